# Optimizing an MI355X kernel written in HIP

```python
import jax, jax.numpy as jnp
from jax import lax
import numpy as np

D_MODEL = 1024
BATCH = 4
SEQ = 8192
DEPTH = 4

A_HEADS = 4
A_HEAD_DIM = 64
A_WIDTH = A_HEADS * A_HEAD_DIM
B_HEADS = 4
B_HEAD_DIM = 128
B_WIDTH = B_HEADS * B_HEAD_DIM
C_BLOCKS = 4
C_WIDTH = 256
C_BLOCK_DIM = C_WIDTH // C_BLOCKS
D_MIX = A_WIDTH + B_WIDTH + C_WIDTH
IN_SPLITS = (A_WIDTH, A_WIDTH, A_WIDTH, A_WIDTH,
             B_WIDTH, B_WIDTH, B_WIDTH, B_WIDTH, B_HEADS, B_HEADS,
             C_WIDTH, C_WIDTH)
D_IN = 4 * A_WIDTH + 4 * B_WIDTH + 2 * B_HEADS + 2 * C_WIDTH
CONV_K = 4
CHUNK = 64
RG_C = 8.0
D_FF = 4 * D_MODEL
EPS = 1e-6
TINY = 1e-30

kernel_name = "hymba_style_hgrn2_gdn_rglru_hybrid"


def rmsnorm(x, g):
    xf = x.astype(jnp.float32)
    y = xf * lax.rsqrt(jnp.mean(xf * xf, axis=-1, keepdims=True) + EPS)
    return (y * g.astype(jnp.float32)).astype(x.dtype)


def l2norm(x):
    return x * lax.rsqrt(jnp.sum(x * x, axis=-1, keepdims=True) + EPS)


def split_cols(t, sizes):
    offsets = np.cumsum(np.array(sizes))[:-1].tolist()
    return jnp.split(t, offsets, axis=-1)


def causal_depthwise_conv(x, w):
    k = w.shape[0]
    s = x.shape[1]
    xp = jnp.pad(x, ((0, 0), (k - 1, 0), (0, 0)))
    y = xp[:, 0:s] * w[0]
    for j in range(1, k):
        y = y + xp[:, j:j + s] * w[j]
    return y


def masked_exp(mask, t):
    return jnp.where(mask, jnp.exp(jnp.where(mask, t, 0.0)), 0.0)


def to_chunks(t):
    b, s = t.shape[:2]
    t = t.reshape(b, s // CHUNK, CHUNK, *t.shape[2:])
    t = jnp.moveaxis(t, 2, 3)
    return jnp.moveaxis(t, 1, 0)


def from_chunks(t):
    n, b, h, c, d = t.shape
    return jnp.transpose(t, (1, 0, 3, 2, 4)).reshape(b, n * c, h, d)


def hgrn2_chunk(q, k, v, log_f):
    bsz, _, h, dk = q.shape
    dv = v.shape[-1]
    qc, kc, vc = to_chunks(q), to_chunks(k), to_chunks(v)
    cum = jnp.cumsum(to_chunks(log_f), axis=-2)
    cum_last = cum[..., -1:, :]
    q_dec = qc * jnp.exp(cum)
    k_dec = kc * jnp.exp(cum_last - cum)
    chunk_dec = jnp.exp(cum_last[..., 0, :])
    causal = jnp.tril(jnp.ones((CHUNK, CHUNK), dtype=bool))[:, :, None]

    def step(state, xs):
        q_, k_, v_, c_, qd, kd, cd = xs
        diff = c_[..., :, None, :] - c_[..., None, :, :]
        dec = masked_exp(causal, diff)
        attn = jnp.einsum('bhtd,bhsd,bhtsd->bhts', q_, k_, dec)
        o = jnp.einsum('bhtd,bhde->bhte', qd, state) + jnp.einsum('bhts,bhse->bhte', attn, v_)
        state = state * cd[..., :, None] + jnp.einsum('bhsd,bhse->bhde', kd, v_)
        return state, o

    s0 = jnp.zeros((bsz, h, dk, dv), jnp.float32)
    _, o = lax.scan(step, s0, (qc, kc, vc, cum, q_dec, k_dec, chunk_dec))
    return from_chunks(o)


def hgrn2_mixer(q_in, f_in, i_in, g_in, lb, norm_g):
    bsz, s, _ = q_in.shape
    shp = (bsz, s, A_HEADS, A_HEAD_DIM)
    q = jax.nn.silu(q_in.astype(jnp.float32)).reshape(shp)
    fp = f_in.astype(jnp.float32).reshape(shp)
    lbh = lb.astype(jnp.float32).reshape(A_HEADS, A_HEAD_DIM)
    f = lbh + (1.0 - lbh) * jax.nn.sigmoid(fp)
    log_f = jnp.log(jnp.maximum(f, TINY))
    k = (1.0 - lbh) * jax.nn.sigmoid(-fp)
    v = i_in.astype(jnp.float32).reshape(shp)
    o = hgrn2_chunk(q, k, v, log_f)
    o = rmsnorm(o, norm_g) * jax.nn.silu(g_in.astype(jnp.float32).reshape(shp))
    return o.reshape(bsz, s, A_WIDTH)


def gated_delta_chunk(q, k, v, log_alpha, beta):
    bsz, _, h, dk = q.shape
    dv = v.shape[-1]
    qc = to_chunks(q) * (dk ** -0.5)
    kc, vc = to_chunks(k), to_chunks(v)
    gc = jnp.cumsum(to_chunks(log_alpha), axis=-1)
    bc = to_chunks(beta)
    causal = jnp.tril(jnp.ones((CHUNK, CHUNK), dtype=bool))
    strict = jnp.tril(jnp.ones((CHUNK, CHUNK), dtype=bool), -1)
    decay = masked_exp(causal, gc[..., :, None] - gc[..., None, :])
    kb = kc * bc[..., None]
    a_mat = jnp.where(strict, jnp.einsum('nbhtd,nbhsd->nbhts', kb, kc) * decay, 0.0)
    u = lax.linalg.triangular_solve(a_mat, vc * bc[..., None], left_side=True, lower=True,
                                    unit_diagonal=True)
    w = lax.linalg.triangular_solve(a_mat, kb * jnp.exp(gc)[..., None], left_side=True,
                                    lower=True, unit_diagonal=True)
    qk = jnp.einsum('nbhtd,nbhsd->nbhts', qc, kc) * decay
    q_dec = qc * jnp.exp(gc)[..., None]
    k_dec = kc * jnp.exp(gc[..., -1:] - gc)[..., None]
    chunk_dec = jnp.exp(gc[..., -1])

    def step(state, xs):
        qd, kd, qk_, u_, w_, cd = xs
        v_new = u_ - jnp.einsum('bhtd,bhde->bhte', w_, state)
        o = jnp.einsum('bhtd,bhde->bhte', qd, state) + jnp.einsum('bhts,bhse->bhte', qk_, v_new)
        state = state * cd[..., None, None] + jnp.einsum('bhsd,bhse->bhde', kd, v_new)
        return state, o

    s0 = jnp.zeros((bsz, h, dk, dv), jnp.float32)
    _, o = lax.scan(step, s0, (q_dec, k_dec, qk, u, w, chunk_dec))
    return from_chunks(o)


def gdn_mixer(q_in, k_in, v_in, z_in, b_in, a_in, conv_w, a_log, dt_bias, norm_g):
    bsz, s, _ = q_in.shape
    shp = (bsz, s, B_HEADS, B_HEAD_DIM)
    qkv = jnp.concatenate([q_in, k_in, v_in], axis=-1).astype(jnp.float32)
    qkv = jax.nn.silu(causal_depthwise_conv(qkv, conv_w.astype(jnp.float32)))
    q, k, v = split_cols(qkv, (B_WIDTH, B_WIDTH, B_WIDTH))
    q = l2norm(q.reshape(shp))
    k = l2norm(k.reshape(shp))
    v = v.reshape(shp)
    beta = jax.nn.sigmoid(b_in.astype(jnp.float32))
    log_alpha = -jnp.exp(a_log.astype(jnp.float32)) * jax.nn.softplus(
        a_in.astype(jnp.float32) + dt_bias.astype(jnp.float32))
    o = gated_delta_chunk(q, k, v, log_alpha, beta)
    o = rmsnorm(o, norm_g) * jax.nn.silu(z_in.astype(jnp.float32).reshape(shp))
    return o.reshape(bsz, s, B_WIDTH)


def rglru(x, w_a, b_a, w_x, b_x, lam):
    bsz, s, _ = x.shape
    xb = x.reshape(bsz, s, C_BLOCKS, C_BLOCK_DIM)
    r = jax.nn.sigmoid(jnp.einsum('bsnd,nde->bsne', xb, w_a.astype(jnp.float32)).reshape(bsz, s, C_WIDTH)
                       + b_a.astype(jnp.float32))
    i = jax.nn.sigmoid(jnp.einsum('bsnd,nde->bsne', xb, w_x.astype(jnp.float32)).reshape(bsz, s, C_WIDTH)
                       + b_x.astype(jnp.float32))
    log_a = -RG_C * r * jax.nn.softplus(-lam.astype(jnp.float32))
    a = jnp.exp(log_a)
    pos = jnp.arange(s)[None, :, None]
    mult = jnp.where(pos == 0, 1.0, jnp.sqrt(jnp.maximum(-jnp.expm1(2.0 * log_a), EPS)))
    bx = mult * i * x

    def combine(c1, c2):
        a1, b1 = c1
        a2, b2 = c2
        return a1 * a2, a2 * b1 + b2

    _, hs = lax.associative_scan(combine, (a, bx), axis=1)
    return hs


def rglru_mixer(x_in, y_in, conv_w, conv_b, w_a, b_a, w_x, b_x, lam):
    xc = causal_depthwise_conv(x_in.astype(jnp.float32), conv_w.astype(jnp.float32)) + conv_b.astype(jnp.float32)
    h = rglru(xc, w_a, b_a, w_x, b_x, lam)
    return jax.nn.gelu(y_in.astype(jnp.float32), approximate=True) * h


def setup_inputs(seed: int = 0) -> dict:
    key = jax.random.key(seed)
    ks = jax.random.split(key, 24)
    f32 = jnp.float32
    nrm = jax.random.normal
    uni = jax.random.uniform
    x = nrm(ks[0], (BATCH, SEQ, D_MODEL), f32)
    norm1_g = 1.0 + 0.02 * nrm(ks[1], (DEPTH, D_MODEL), f32)
    w_in = nrm(ks[2], (DEPTH, D_MODEL, D_IN), f32) * D_MODEL ** -0.5
    hgrn_lb_logits = 0.1 * nrm(ks[3], (DEPTH, A_WIDTH), f32)
    hgrn_norm_g = 1.0 + 0.02 * nrm(ks[4], (DEPTH, A_HEAD_DIM), f32)
    gdn_conv_w = nrm(ks[5], (DEPTH, CONV_K, 3 * B_WIDTH), f32) * CONV_K ** -0.5
    gdn_a_log = jnp.log(uni(ks[6], (DEPTH, B_HEADS), f32, 1.0, 16.0))
    dt = jnp.exp(uni(ks[7], (DEPTH, B_HEADS), f32, float(np.log(1e-3)), float(np.log(1e-1))))
    gdn_dt_bias = dt + jnp.log(-jnp.expm1(-dt))
    gdn_norm_g = 1.0 + 0.02 * nrm(ks[8], (DEPTH, B_HEAD_DIM), f32)
    lru_conv_w = nrm(ks[9], (DEPTH, CONV_K, C_WIDTH), f32) * CONV_K ** -0.5
    lru_conv_b = 0.01 * nrm(ks[10], (DEPTH, C_WIDTH), f32)
    lru_w_a = nrm(ks[11], (DEPTH, C_BLOCKS, C_BLOCK_DIM, C_BLOCK_DIM), f32) * C_BLOCK_DIM ** -0.5
    lru_b_a = 0.01 * nrm(ks[12], (DEPTH, C_WIDTH), f32)
    lru_w_x = nrm(ks[13], (DEPTH, C_BLOCKS, C_BLOCK_DIM, C_BLOCK_DIM), f32) * C_BLOCK_DIM ** -0.5
    lru_b_x = 0.01 * nrm(ks[14], (DEPTH, C_WIDTH), f32)
    a_c = uni(ks[15], (DEPTH, C_WIDTH), f32, 0.9, 0.999)
    s_a = a_c ** (1.0 / RG_C)
    lru_lambda = jnp.log(s_a) - jnp.log1p(-s_a)
    w_out = nrm(ks[16], (DEPTH, D_MIX, D_MODEL), f32) * D_MIX ** -0.5
    norm2_g = 1.0 + 0.02 * nrm(ks[17], (DEPTH, D_MODEL), f32)
    w_up = nrm(ks[18], (DEPTH, D_MODEL, D_FF), f32) * D_MODEL ** -0.5
    w_down = nrm(ks[19], (DEPTH, D_FF, D_MODEL), f32) * D_FF ** -0.5
    final_norm_g = 1.0 + 0.02 * nrm(ks[20], (D_MODEL,), f32)
    return {"x": x, "norm1_g": norm1_g, "w_in": w_in, "hgrn_lb_logits": hgrn_lb_logits,
            "hgrn_norm_g": hgrn_norm_g, "gdn_conv_w": gdn_conv_w, "gdn_a_log": gdn_a_log,
            "gdn_dt_bias": gdn_dt_bias, "gdn_norm_g": gdn_norm_g, "lru_conv_w": lru_conv_w,
            "lru_conv_b": lru_conv_b, "lru_w_a": lru_w_a, "lru_b_a": lru_b_a, "lru_w_x": lru_w_x,
            "lru_b_x": lru_b_x, "lru_lambda": lru_lambda, "w_out": w_out, "norm2_g": norm2_g,
            "w_up": w_up, "w_down": w_down, "final_norm_g": final_norm_g}


def reference(x, norm1_g, w_in, hgrn_lb_logits, hgrn_norm_g, gdn_conv_w, gdn_a_log, gdn_dt_bias,
              gdn_norm_g, lru_conv_w, lru_conv_b, lru_w_a, lru_b_a, lru_w_x, lru_b_x, lru_lambda,
              w_out, norm2_g, w_up, w_down, final_norm_g):
    p = jax.nn.softmax(hgrn_lb_logits.astype(jnp.float32), axis=0)
    lower_bounds = jnp.clip(jnp.cumsum(p, axis=0) - p[0], 0.0, 1.0 - EPS)
    for l in range(DEPTH):
        h = rmsnorm(x, norm1_g[l])
        proj = h @ w_in[l]
        (aq, af, ai, ag, bq, bk, bv, bz, bb, ba, cx, cy) = split_cols(proj, IN_SPLITS)
        o_a = hgrn2_mixer(aq, af, ai, ag, lower_bounds[l], hgrn_norm_g[l])
        o_b = gdn_mixer(bq, bk, bv, bz, bb, ba, gdn_conv_w[l], gdn_a_log[l], gdn_dt_bias[l], gdn_norm_g[l])
        o_c = rglru_mixer(cx, cy, lru_conv_w[l], lru_conv_b[l], lru_w_a[l], lru_b_a[l],
                          lru_w_x[l], lru_b_x[l], lru_lambda[l])
        mixed = jnp.concatenate([o_a, o_b, o_c], axis=-1).astype(x.dtype)
        x = x + mixed @ w_out[l]
        h2 = rmsnorm(x, norm2_g[l])
        x = x + jnp.square(jax.nn.relu(h2 @ w_up[l])) @ w_down[l]
    return rmsnorm(x, final_norm_g)
```

```cpp
#include <hip/hip_runtime.h>
#include <hip/hip_cooperative_groups.h>
#include <cstdio>
namespace cg = cooperative_groups;
namespace pg8 {
#define PG8_LAS __attribute__((address_space(3)))
typedef unsigned short bf16_t;
typedef short bf16x8 __attribute__((ext_vector_type(8)));
typedef float f32x4 __attribute__((ext_vector_type(4)));
typedef unsigned u32x4 __attribute__((ext_vector_type(4)));
constexpr int BM = 256, BK = 64, HALF = 128, HTB = HALF * BK * 2  , STAGE_BYTES = 8 * HTB, NXCD = 8, WGM = 8;

__host__ __device__ __forceinline__ int lds_byte(int r, int c) { const int st = (r >> 4) * 2 + (c >> 5), rr = r & 15, cc = c & 31, ob = rr * 64 + cc * 2; return st * 1024 + (ob ^ (((ob >> 9) & 1) << 5)); }
__host__ __device__ __forceinline__ void stage_rc(int b, int& R, int& C) { const int st = b / 1024, sb = b % 1024, swz = sb ^ (((sb >> 9) & 1) << 5); R = (st >> 1) * 16 + swz / 64; C = (st & 1) * 32 + (swz % 64) / 2; }
__host__ __device__ __forceinline__ int perm32(int rho) { const int n = rho >> 4, i = rho & 15; return 8 * (i >> 2) + 4 * n + (i & 3); }

struct Unit { int pm, pn; };
struct Gemm { const bf16_t* A; const bf16_t* Bt; int M, N, K; };

struct StaticOrder {
    int nM, nN, nwg, G, c;
    __host__ __device__ void init(int M, int N, int G_, int c_) { nM = M / BM; nN = N / BM; nwg = nM * nN; G = G_; c = c_; }
    __host__ __device__ bool next(int i, Unit& u) const {
        const long L = (long)i * G + c; if (L >= nwg) return false;
        int wgid = (int)L; { const int q = nwg / NXCD, r = nwg % NXCD, xcd = wgid % NXCD, off = wgid / NXCD; wgid = (xcd < r ? xcd * (q + 1) : r * (q + 1) + (xcd - r) * q) + off; }
        const int nig = WGM * nN, gid = wgid / nig, fm = gid * WGM, gsz = (nM - fm) < WGM ? (nM - fm) : WGM;
        u.pm = fm + ((wgid % nig) % gsz); u.pn = (wgid % nig) / gsz; return true;
    }
    __device__ __forceinline__ void a_ready(const Unit&) const {}
    __device__ __forceinline__ void done(const Unit&) const {}
};
__device__ __forceinline__ unsigned cvt_pk_bf16(float lo, float hi) { unsigned r; asm volatile("v_cvt_pk_bf16_f32 %0, %1, %2" : "=v"(r) : "v"(lo), "v"(hi)); return r; }
__device__ __forceinline__ int TID() { int t = threadIdx.x; asm volatile("" : "+v"(t)); return t; }
__device__ __forceinline__ int BID() { int t = blockIdx.x; asm volatile("" : "+s"(t)); return t; }
template <class Epi, class Sched, bool ALIGN_EPI = false, bool SP2 = false>
__device__ __forceinline__ void gemm_phase(PG8_LAS unsigned char* lds, const Gemm g, const Sched& S, const Epi& E) {
    const int tid = TID(), wid = __builtin_amdgcn_readfirstlane(tid >> 6), lane = tid & 63, wr = wid >> 2, wc = wid & 3, fr = lane & 15, fq = lane >> 4;
    const int K = g.K, nt = K / BK;
    unsigned voffA[2], voffB[2];
#pragma unroll
    for (int i = 0; i < 2; ++i) { int R, C; stage_rc(tid * 16 + i * 8192, R, C); const int Rb = Epi::PERM ? ((R & ~31) + perm32(R & 31)) : R;
        voffA[i] = (unsigned)(R * K + C) * 2u; voffB[i] = (unsigned)(Rb * K + C) * 2u; }
    const size_t kstep = (size_t)(BK * 2);
    const size_t hstep = (size_t)HALF * K * 2;
    const size_t tstep = 2 * hstep;
    const unsigned ldsw = (unsigned)wid * 1024u;
    const int aoff = lds_byte(wr * 64 + fr, fq * 8), boff = lds_byte(wc * 32 + fr, fq * 8);
#define PG8_SA(b, h) (((b) * 2 + (h)) * HTB)
#define PG8_SB(b, h) ((4 + (b) * 2 + (h)) * HTB)
#define PG8_STAGE(bufoff, gbase, voff) do { _Pragma("unroll") for (int _i = 0; _i < 2; ++_i) \
        __builtin_amdgcn_global_load_lds((const unsigned*)((const char*)(gbase) + (voff)[_i]), (PG8_LAS unsigned*)(lds + (bufoff) + ldsw + _i * 8192), 16, 0, 0); } while (0)
#define PG8_LDA(dst, b, h) do { _Pragma("unroll") for (int m = 0; m < 4; ++m) _Pragma("unroll") for (int k = 0; k < 2; ++k) dst[m][k] = *(const PG8_LAS bf16x8*)(lds + PG8_SA(b, h) + aoff + m * 2048 + k * 1024); } while (0)
#define PG8_LDB(dst, b, h) do { _Pragma("unroll") for (int n = 0; n < 2; ++n) _Pragma("unroll") for (int k = 0; k < 2; ++k) dst[n][k] = *(const PG8_LAS bf16x8*)(lds + PG8_SB(b, h) + boff + n * 2048 + k * 1024); } while (0)
#define PG8_MMA(ai, bj, At, Bt) do { __builtin_amdgcn_s_setprio(1); _Pragma("unroll") for (int m = 0; m < 4; ++m) _Pragma("unroll") for (int n = 0; n < 2; ++n) _Pragma("unroll") for (int k = 0; k < 2; ++k) \
        acc[ai][bj][m][n] = __builtin_amdgcn_mfma_f32_16x16x32_bf16(Bt[n][k], At[m][k], acc[ai][bj][m][n], 0, 0, 0); __builtin_amdgcn_s_setprio(0); } while (0)
#define PG8_WAIT_V(n) asm volatile("s_waitcnt vmcnt(" #n ")" ::: "memory")
#define PG8_WAIT_L(n) asm volatile("s_waitcnt lgkmcnt(" #n ")" ::: "memory")
#define PG8_BAR __builtin_amdgcn_s_barrier()
#define PG8_SCHED __builtin_amdgcn_sched_barrier(0)
    Unit cur, nxt; int ui = 0;
    if (!S.next(0, cur)) return;
    f32x4 acc[2][2][4][2];
#pragma unroll
    for (int a = 0; a < 2; ++a)
#pragma unroll
        for (int b = 0; b < 2; ++b)
#pragma unroll
            for (int m = 0; m < 4; ++m)
#pragma unroll
                for (int n = 0; n < 2; ++n) acc[a][b][m][n] = (f32x4){0.f, 0.f, 0.f, 0.f};
    bf16x8 At[4][2], B0[2][2], B1[2][2];
    const char* cA = (const char*)g.A + (size_t)cur.pm * tstep; const char* cB = (const char*)g.Bt + (size_t)cur.pn * tstep;
    S.a_ready(cur);
    if constexpr (SP2) {
        PG8_STAGE(PG8_SB(0, 0), cB, voffB); PG8_STAGE(PG8_SB(0, 1), cB + hstep, voffB); PG8_STAGE(PG8_SA(0, 0), cA, voffA); PG8_STAGE(PG8_SA(0, 1), cA + hstep, voffA);
        if (wr == 1) PG8_BAR;
        PG8_WAIT_V(2); PG8_BAR;
        PG8_STAGE(PG8_SB(1, 0), cB + kstep, voffB); PG8_STAGE(PG8_SA(1, 0), cA + kstep, voffA); PG8_STAGE(PG8_SB(1, 1), cB + hstep + kstep, voffB);
        PG8_WAIT_V(6); PG8_BAR;
    } else {
        PG8_STAGE(PG8_SB(0, 0), cB, voffB); PG8_STAGE(PG8_SA(0, 0), cA, voffA); PG8_STAGE(PG8_SB(0, 1), cB + hstep, voffB); PG8_STAGE(PG8_SA(0, 1), cA + hstep, voffA);
        if (wr == 1) PG8_BAR;
        PG8_WAIT_V(4); PG8_BAR;
        PG8_STAGE(PG8_SB(1, 0), cB + kstep, voffB); PG8_STAGE(PG8_SA(1, 0), cA + kstep, voffA); PG8_STAGE(PG8_SB(1, 1), cB + hstep + kstep, voffB);
        PG8_WAIT_V(6); PG8_BAR;
    }
    for (;;) {
        const bool has_next = S.next(ui + 1, nxt);
        const char* nA = has_next ? (const char*)g.A + (size_t)nxt.pm * tstep : cA; const char* nB = has_next ? (const char*)g.Bt + (size_t)nxt.pn * tstep : cB;
        for (int t = 0; t < nt; t += 2) {
            const bool last = (t == nt - 2);
            const char* a1 = cA + (size_t)(t + 1) * kstep;
            const char* a2 = last ? nA : cA + (size_t)(t + 2) * kstep; const char* b2 = last ? nB : cB + (size_t)(t + 2) * kstep;
            const char* a3 = a2 + kstep; const char* b3 = b2 + kstep;
            if (last && has_next) S.a_ready(nxt);
            if constexpr (SP2) {
            PG8_LDB(B0, 0, 0); PG8_LDB(B1, 0, 1); PG8_SCHED; PG8_LDA(At, 0, 0); PG8_STAGE(PG8_SA(1, 1), a1 + hstep, voffA);
            PG8_WAIT_V(8); PG8_WAIT_L(0); PG8_BAR; PG8_MMA(0, 0, At, B0); PG8_MMA(0, 1, At, B1); PG8_BAR; PG8_SCHED;
            PG8_LDA(At, 0, 1); PG8_STAGE(PG8_SB(0, 0), b2, voffB); PG8_STAGE(PG8_SB(0, 1), b2 + hstep, voffB); PG8_STAGE(PG8_SA(0, 0), a2, voffA);
            PG8_WAIT_V(8); PG8_WAIT_L(0); PG8_BAR; PG8_MMA(1, 0, At, B0); PG8_MMA(1, 1, At, B1); PG8_BAR; PG8_SCHED;
            PG8_LDB(B0, 1, 0); PG8_LDB(B1, 1, 1); PG8_SCHED; PG8_LDA(At, 1, 0); PG8_STAGE(PG8_SA(0, 1), a2 + hstep, voffA);
            PG8_WAIT_V(8); PG8_WAIT_L(0); PG8_BAR; PG8_MMA(0, 0, At, B0); PG8_MMA(0, 1, At, B1); PG8_BAR; PG8_SCHED;
            PG8_LDA(At, 1, 1); PG8_STAGE(PG8_SB(1, 0), b3, voffB); PG8_STAGE(PG8_SB(1, 1), b3 + hstep, voffB); PG8_STAGE(PG8_SA(1, 0), a3, voffA);
            PG8_WAIT_V(8); PG8_WAIT_L(0); PG8_BAR; PG8_MMA(1, 0, At, B0); PG8_MMA(1, 1, At, B1); PG8_BAR; PG8_SCHED;
            } else {
            PG8_LDB(B0, 0, 0); PG8_SCHED; PG8_LDA(At, 0, 0); PG8_STAGE(PG8_SA(1, 1), a1 + hstep, voffA);
            PG8_WAIT_L(8); PG8_BAR; PG8_WAIT_L(0); PG8_MMA(0, 0, At, B0); PG8_BAR; PG8_SCHED;
            PG8_LDB(B1, 0, 1); PG8_STAGE(PG8_SB(0, 0), b2, voffB);
            PG8_BAR; PG8_WAIT_L(0); PG8_MMA(0, 1, At, B1); PG8_BAR;
            PG8_LDA(At, 0, 1); PG8_STAGE(PG8_SA(0, 0), a2, voffA);
            PG8_BAR; PG8_WAIT_L(0); PG8_MMA(1, 0, At, B0); PG8_BAR; PG8_SCHED;
            PG8_STAGE(PG8_SB(0, 1), b2 + hstep, voffB);
            PG8_WAIT_V(6); PG8_BAR; PG8_MMA(1, 1, At, B1); PG8_BAR;
            PG8_LDB(B0, 1, 0); PG8_SCHED; PG8_LDA(At, 1, 0); PG8_STAGE(PG8_SA(0, 1), a2 + hstep, voffA);
            PG8_WAIT_L(8); PG8_BAR; PG8_WAIT_L(0); PG8_MMA(0, 0, At, B0); PG8_BAR; PG8_SCHED;
            PG8_LDB(B1, 1, 1); PG8_STAGE(PG8_SB(1, 0), b3, voffB);
            PG8_BAR; PG8_WAIT_L(0); PG8_MMA(0, 1, At, B1); PG8_BAR;
            PG8_LDA(At, 1, 1); PG8_STAGE(PG8_SA(1, 0), a3, voffA);
            PG8_BAR; PG8_WAIT_L(0); PG8_MMA(1, 0, At, B0); PG8_BAR; PG8_SCHED;
            PG8_STAGE(PG8_SB(1, 1), b3 + hstep, voffB);
            PG8_WAIT_V(6); PG8_BAR; PG8_MMA(1, 1, At, B1); PG8_BAR;
            }
        }
        if constexpr (ALIGN_EPI) { if (wr == 0) PG8_BAR; }
        if constexpr (!Epi::AFTER_DRAIN) { E(acc, cur, wr, wc, fr, fq); S.done(cur); }
        if (!has_next) break;
#pragma unroll
        for (int a = 0; a < 2; ++a)
#pragma unroll
            for (int b = 0; b < 2; ++b)
#pragma unroll
                for (int m = 0; m < 4; ++m)
#pragma unroll
                    for (int n = 0; n < 2; ++n) acc[a][b][m][n] = (f32x4){0.f, 0.f, 0.f, 0.f};
        cur = nxt; cA = nA; cB = nB; ++ui;
        if constexpr (ALIGN_EPI) { if (wr == 1) PG8_BAR; }
    }
    PG8_WAIT_V(0);
    if constexpr (!ALIGN_EPI) { if (wr == 0) PG8_BAR; }
    PG8_BAR;
    if constexpr (Epi::AFTER_DRAIN) { E.fused(acc, cur, wr, wc, fr, fq, lds, wid, lane); S.done(cur); }
#undef PG8_SA
#undef PG8_SB
#undef PG8_STAGE
#undef PG8_LDA
#undef PG8_LDB
#undef PG8_MMA
#undef PG8_WAIT_V
#undef PG8_WAIT_L
#undef PG8_BAR
#undef PG8_SCHED
}
}

using pg8::TID; using pg8::BID; using pg8::bf16_t; using pg8::f32x4; using pg8::u32x4; using pg8::cvt_pk_bf16;
constexpr int T = 32768, SEQ = 8192, DM = 1024, DIN = 3592, NP = 3584, DFF = 4096, DEPTH = 4;
constexpr float EPS = 1e-6f;
constexpr size_t MiB = (size_t)1 << 20;
constexpr size_t WS_XB = 0, WS_WIN = 64 * MiB, WS_WOUT = 71 * MiB, WS_WUP = 73 * MiB, WS_WDN = 81 * MiB, WS_R = 89 * MiB, WS_Z = WS_R + 224 * MiB, WS_HS = 480 * MiB, WS_HS2 = WS_HS, WS_QK = 496 * MiB,
                 WS_MIX = 345 * MiB, WS_S1 = 409 * MiB, WS_GATES = 473 * MiB, WS_SS = 474 * MiB, WS_HCD = 478 * MiB, WS_LAGG = WS_HCD + MiB / 2, WS_LCAR = WS_LAGG + MiB, WS_END = 512 * MiB;
constexpr int C_AQ = 0, C_AF = 256, C_AI = 512, C_AG = 768, C_BQ = 1024, C_BK = 1536, C_BV = 2048, C_BZ = 2560, C_CX = 3072, C_CY = 3328;
enum { I_X = 0, I_N1G, I_WIN, I_LB, I_HNG, I_GCW, I_GALOG, I_GDT, I_GNG, I_LCW, I_LCB, I_LWA, I_LBA, I_LWX, I_LBX, I_LLAM, I_WOUT, I_N2G, I_WUP, I_WDN, I_FNG };
struct Params { const float* in[21]; float* out; unsigned char* ws; };

__device__ __forceinline__ float bf2f(bf16_t v) { return __uint_as_float(((unsigned)v) << 16); }
__device__ __forceinline__ bf16_t f2bf(float f) { unsigned u = __float_as_uint(f); u += 0x7FFFu + ((u >> 16) & 1u); return (bf16_t)(u >> 16); }
__device__ __forceinline__ float lo_bf(unsigned w) { return __uint_as_float(w << 16); }
__device__ __forceinline__ float hi_bf(unsigned w) { return __uint_as_float(w & 0xffff0000u); }
__device__ __forceinline__ float sigm(float x) { return 1.f / (1.f + __expf(-x)); }
__device__ __forceinline__ float silu(float x) { return x * sigm(x); }
__device__ __forceinline__ float softplus(float x) { return fmaxf(x, 0.f) + log1pf(__expf(-fabsf(x))); }
__device__ __forceinline__ float gelu_tanh(float y) { const float u = 0.7978845608028654f * (y + 0.044715f * y * y * y); return 0.5f * y * (1.f + tanhf(u)); }
__device__ __forceinline__ float wave_sum(float v) {
#pragma unroll
    for (int o = 32; o; o >>= 1) v += __shfl_xor(v, o);
    return v;
}
__device__ __forceinline__ float row_rstd(const float* ssp, int row) {
    const f32x4 a = *(const f32x4*)(ssp + (size_t)row * 16), b = *(const f32x4*)(ssp + (size_t)row * 16 + 4), c = *(const f32x4*)(ssp + (size_t)row * 16 + 8), d = *(const f32x4*)(ssp + (size_t)row * 16 + 12);
    const f32x4 s = (a + b) + (c + d);
    return rsqrtf(((s[0] + s[1]) + (s[2] + s[3])) * (1.f / 1024.f) + EPS);
}
__device__ __forceinline__ float lower_bound(const float* lbl, int l, int c) {
    const float a0 = lbl[c], a1 = lbl[256 + c], a2 = lbl[512 + c], a3 = lbl[768 + c];
    const float m = fmaxf(fmaxf(a0, a1), fmaxf(a2, a3));
    const float e0 = expf(a0 - m), e1 = expf(a1 - m), e2 = expf(a2 - m), e3 = expf(a3 - m);
    const float inv = 1.f / (e0 + e1 + e2 + e3);
    float s = 0.f; if (l >= 1) s += e1; if (l >= 2) s += e2; if (l >= 3) s += e3;
    return fminf(fmaxf(s * inv, 0.f), 1.f - EPS);
}

template <int ACT  > struct EpiScaled {
    static constexpr bool PERM = true, AFTER_DRAIN = false;
    bf16_t* O; int ldc; const float* ss;
    __device__ __forceinline__ void operator()(const f32x4 (&acc)[2][2][4][2], const pg8::Unit& u, int wr, int wc, int fr, int fq) const {
        const int row0 = u.pm * 256 + wr * 64 + fr, col0 = u.pn * 256 + wc * 32 + 8 * fq;
#pragma unroll
        for (int ai = 0; ai < 2; ++ai)
#pragma unroll
            for (int m = 0; m < 4; ++m) {
                const int row = row0 + ai * 128 + m * 16;
                float sq; { const f32x4 a = *(const f32x4*)(ss + (size_t)row * 16 + fq * 4); sq = (a[0] + a[1]) + (a[2] + a[3]); }
                sq += __shfl_xor(sq, 16); sq += __shfl_xor(sq, 32);
                const float rs = rsqrtf(sq * (1.f / 1024.f) + EPS);
                bf16_t* rowp = O + (size_t)row * ldc + col0;
#pragma unroll
                for (int bj = 0; bj < 2; ++bj) {
                    f32x4 v0 = acc[ai][bj][m][0] * rs, v1 = acc[ai][bj][m][1] * rs;
                    if (ACT == 1) {
#pragma unroll
                        for (int j = 0; j < 4; ++j) { const float a = fmaxf(v0[j], 0.f), b = fmaxf(v1[j], 0.f); v0[j] = a * a; v1[j] = b * b; }
                    }
                    u32x4 w; w.x = cvt_pk_bf16(v0[0], v0[1]); w.y = cvt_pk_bf16(v0[2], v0[3]); w.z = cvt_pk_bf16(v1[0], v1[1]); w.w = cvt_pk_bf16(v1[2], v1[3]);
                    *(u32x4*)(rowp + bj * 128) = w;
                }
            }
    }
};
struct EpiResid {
    static constexpr bool PERM = true, AFTER_DRAIN = false;
    const float* Xsrc; float* X; bf16_t* XB; float* ssout;
    __device__ __forceinline__ void operator()(const f32x4 (&acc)[2][2][4][2], const pg8::Unit& u, int wr, int wc, int fr, int fq) const {
        const int row0 = u.pm * 256 + wr * 64 + fr, col0 = u.pn * 256 + wc * 32 + 8 * fq;
#pragma unroll
        for (int ai = 0; ai < 2; ++ai)
#pragma unroll
            for (int m = 0; m < 4; ++m) {
                const int row = row0 + ai * 128 + m * 16;
                const float* sp = Xsrc + (size_t)row * 1024 + col0; float* xp = X + (size_t)row * 1024 + col0; bf16_t* bp = XB + (size_t)row * 1024 + col0;
                float sq = 0.f;
#pragma unroll
                for (int bj = 0; bj < 2; ++bj) {
                    f32x4 v0 = *(const f32x4*)(sp + bj * 128) + acc[ai][bj][m][0], v1 = *(const f32x4*)(sp + bj * 128 + 4) + acc[ai][bj][m][1];
                    *(f32x4*)(xp + bj * 128) = v0; *(f32x4*)(xp + bj * 128 + 4) = v1;
                    u32x4 w; w.x = cvt_pk_bf16(v0[0], v0[1]); w.y = cvt_pk_bf16(v0[2], v0[3]); w.z = cvt_pk_bf16(v1[0], v1[1]); w.w = cvt_pk_bf16(v1[2], v1[3]);
                    *(u32x4*)(bp + bj * 128) = w;
#pragma unroll
                    for (int j = 0; j < 4; ++j) sq += v0[j] * v0[j] + v1[j] * v1[j];
                }
                sq += __shfl_xor(sq, 16); sq += __shfl_xor(sq, 32);
                if (fq == 0) ssout[(size_t)row * 16 + u.pn * 4 + wc] = sq;
            }
    }
};

__device__ void convert_w(const float* W, int ldw, int gate_skip  , const float* g, bf16_t* Bt, int N, int K, float* tile  , int first, int stride) {
    const int tid = TID(), ntn = N / 64, ntk = K / 64, ntiles = ntn * ntk;
    const int r0 = tid >> 4, c4 = (tid & 15) * 4;
    f32x4 nv[2];
    if (first < ntiles) { const int tn = first % ntn, tk = first / ntn, scol = tn * 64 + ((gate_skip && tn * 64 >= 3072) ? 8 : 0);
        nv[0] = *(const f32x4*)(W + (size_t)(tk * 64 + r0) * ldw + scol + c4); nv[1] = *(const f32x4*)(W + (size_t)(tk * 64 + r0 + 32) * ldw + scol + c4); }
    for (int ti = first; ti < ntiles; ti += stride) {
        const int tn = ti % ntn, tk = ti / ntn;
        const f32x4 v0 = nv[0], v1 = nv[1];
        if (ti + stride < ntiles) { const int t2 = ti + stride, tn2 = t2 % ntn, tk2 = t2 / ntn, scol2 = tn2 * 64 + ((gate_skip && tn2 * 64 >= 3072) ? 8 : 0);
            nv[0] = *(const f32x4*)(W + (size_t)(tk2 * 64 + r0) * ldw + scol2 + c4); nv[1] = *(const f32x4*)(W + (size_t)(tk2 * 64 + r0 + 32) * ldw + scol2 + c4); }
        __syncthreads();
        { float* tp = tile + r0 * 65 + c4; tp[0] = v0[0]; tp[1] = v0[1]; tp[2] = v0[2]; tp[3] = v0[3]; }
        { float* tp = tile + (r0 + 32) * 65 + c4; tp[0] = v1[0]; tp[1] = v1[1]; tp[2] = v1[2]; tp[3] = v1[3]; }
        __syncthreads();
        const int n = tid >> 3, k8 = (tid & 7) * 8;
        float v[8];
#pragma unroll
        for (int j = 0; j < 8; ++j) { v[j] = tile[(k8 + j) * 65 + n]; if (g) v[j] *= g[tk * 64 + k8 + j]; }
        u32x4 w; w.x = cvt_pk_bf16(v[0], v[1]); w.y = cvt_pk_bf16(v[2], v[3]); w.z = cvt_pk_bf16(v[4], v[5]); w.w = cvt_pk_bf16(v[6], v[7]);
        *(u32x4*)(Bt + (size_t)(tn * 64 + n) * K + tk * 64 + k8) = w;
    }
    __syncthreads();
}

__device__ void phase_init(const Params& p, unsigned char* smem) {
    const int tid = TID(), lane = tid & 63, gw = BID() * 8 + (tid >> 6), nw = gridDim.x * 8;
    float* ss = (float*)(p.ws + WS_SS);
    bf16_t* xb = (bf16_t*)(p.ws + WS_XB);
    for (int row0 = gw; row0 < T; row0 += 4 * nw) {
        f32x4 v[4][4];
#pragma unroll
        for (int r = 0; r < 4; ++r) { const int row = row0 + r * nw;
#pragma unroll
            for (int i = 0; i < 4; ++i) v[r][i] = row < T ? *(const f32x4*)(p.in[I_X] + (size_t)row * 1024 + (i * 64 + lane) * 4) : (f32x4){0.f, 0.f, 0.f, 0.f}; }
#pragma unroll
        for (int r = 0; r < 4; ++r) { const int row = row0 + r * nw;
            if (row < T) {
                bf16_t* brow = xb + (size_t)row * 1024; float sq = 0.f;
#pragma unroll
                for (int i = 0; i < 4; ++i) {
                    uint2 w; w.x = cvt_pk_bf16(v[r][i][0], v[r][i][1]); w.y = cvt_pk_bf16(v[r][i][2], v[r][i][3]);
                    *(uint2*)(brow + (i * 64 + lane) * 4) = w;
                    sq += v[r][i][0] * v[r][i][0] + v[r][i][1] * v[r][i][1] + v[r][i][2] * v[r][i][2] + v[r][i][3] * v[r][i][3];
                }
                sq = wave_sum(sq);
                if (lane < 16) ss[(size_t)row * 16 + lane] = lane == 0 ? sq : 0.f;
            } }
    }
    convert_w(p.in[I_WIN], DIN, 1, p.in[I_N1G], (bf16_t*)(p.ws + WS_WIN), NP, DM, (float*)smem, BID(), gridDim.x);
}

__device__ void phase_gates(const Params& p, int l, unsigned char* smem) {
    const int tid = TID(), lane = tid & 63, wv = tid >> 6;
    float* wg = (float*)smem;
    const float* W = p.in[I_WIN] + (size_t)l * DM * DIN; const float* g = p.in[I_N1G] + l * DM;
    __syncthreads();
    for (int i = tid; i < 8192; i += 512) { const int j = i & 7, k = i >> 3; wg[j * 1024 + k] = W[(size_t)k * DIN + 3072 + j] * g[k]; }
    __syncthreads();
    const bf16_t* xb = (const bf16_t*)(p.ws + WS_XB); const float* ss = (const float*)(p.ws + WS_SS); float* gates = (float*)(p.ws + WS_GATES);
    for (int t = BID() * 8 + wv; t < T; t += gridDim.x * 8) {
        float acc[8];
#pragma unroll
        for (int j = 0; j < 8; ++j) acc[j] = 0.f;
#pragma unroll
        for (int c = 0; c < 2; ++c) {
            const u32x4 xv = *(const u32x4*)(xb + (size_t)t * 1024 + c * 512 + lane * 8);
            float xf[8] = {lo_bf(xv.x), hi_bf(xv.x), lo_bf(xv.y), hi_bf(xv.y), lo_bf(xv.z), hi_bf(xv.z), lo_bf(xv.w), hi_bf(xv.w)};
#pragma unroll
            for (int j = 0; j < 8; ++j) {
                const f32x4 w0 = *(const f32x4*)(wg + j * 1024 + c * 512 + lane * 8), w1 = *(const f32x4*)(wg + j * 1024 + c * 512 + lane * 8 + 4);
                acc[j] += xf[0] * w0[0] + xf[1] * w0[1] + xf[2] * w0[2] + xf[3] * w0[3] + xf[4] * w1[0] + xf[5] * w1[1] + xf[6] * w1[2] + xf[7] * w1[3];
            }
        }
        float mine = 0.f;
#pragma unroll
        for (int j = 0; j < 8; ++j) { const float s = wave_sum(acc[j]); if (lane == j) mine = s; }
        if (lane < 8) {
            const float val = mine * row_rstd(ss, t);
            float o;
            if (lane < 4) o = sigm(val);
            else { const int h = lane - 4; o = -expf(p.in[I_GALOG][l * 4 + h]) * softplus(val + p.in[I_GDT][l * 4 + h]); }
            gates[(size_t)t * 8 + lane] = o;
        }
    }
    __syncthreads();
}

__device__ void gdn_qk_prep(const Params& p, int l) {
    const int tid = TID(), lane = tid & 63, wv = tid >> 6;
    const bf16_t* proj = (const bf16_t*)(p.ws + WS_R);
    bf16_t* s1 = (bf16_t*)(p.ws + WS_S1);
    {
        const int cc = wv * 128 + lane * 2;
        const float* cw = p.in[I_GCW] + (size_t)l * 4 * 1536;
        float w[4][2];
#pragma unroll
        for (int j = 0; j < 4; ++j) { w[j][0] = cw[j * 1536 + cc]; w[j][1] = cw[j * 1536 + cc + 1]; }
        const float post = wv < 4 ? 0.08838834764831845f : 1.f;
        for (int tile = BID(); tile < T / 128; tile += gridDim.x) {
            const int t0 = tile * 128;
            float x[3][2];
#pragma unroll
            for (int j = 0; j < 3; ++j) {
                if ((t0 % SEQ) == 0) { x[j][0] = 0.f; x[j][1] = 0.f; }
                else { const unsigned v = *(const unsigned*)(proj + (size_t)(t0 - 3 + j) * NP + C_BQ + cc); x[j][0] = lo_bf(v); x[j][1] = hi_bf(v); }
            }
            for (int t = t0; t < t0 + 128; ++t) {
                const unsigned v = *(const unsigned*)(proj + (size_t)t * NP + C_BQ + cc);
                const float a = lo_bf(v), b = hi_bf(v);
                const float y0 = silu(w[0][0] * x[0][0] + w[1][0] * x[1][0] + w[2][0] * x[2][0] + w[3][0] * a);
                const float y1 = silu(w[0][1] * x[0][1] + w[1][1] * x[1][1] + w[2][1] * x[2][1] + w[3][1] * b);
                const float r = rsqrtf(wave_sum(y0 * y0 + y1 * y1) + EPS) * post;
                *(unsigned*)(s1 + (size_t)t * 1024 + cc) = cvt_pk_bf16(y0 * r, y1 * r);
                x[0][0] = x[1][0]; x[0][1] = x[1][1]; x[1][0] = x[2][0]; x[1][1] = x[2][1]; x[2][0] = a; x[2][1] = b;
            }
        }
    }
}

__device__ void gdn_naive(const Params& p, int l, int item) {
    const int lane = TID() & 63, dg = lane >> 4, e = lane & 15;
    const int b = item >> 5, h = (item >> 3) & 3, eg = item & 7, ce = h * 128 + eg * 16 + e;
    const bf16_t* proj = (const bf16_t*)(p.ws + WS_R); const bf16_t* s1 = (const bf16_t*)(p.ws + WS_S1); const float* gates = (const float*)(p.ws + WS_GATES);
    bf16_t* mix = (bf16_t*)(p.ws + WS_MIX);
    const float* cw = p.in[I_GCW] + (size_t)l * 4 * 1536 + 1024 + ce;
    const float w0 = cw[0], w1 = cw[1536], w2 = cw[2 * 1536], w3 = cw[3 * 1536];
    float S[32];
#pragma unroll
    for (int i = 0; i < 32; ++i) S[i] = 0.f;
    float v0 = 0.f, v1 = 0.f, v2 = 0.f;
    const size_t tb = (size_t)b * SEQ;
    u32x4 kn[4], qn[4]; float vn, bn, an;
    {
        const bf16_t* kp = s1 + tb * 1024 + 512 + h * 128 + dg * 32; const bf16_t* qp = s1 + tb * 1024 + h * 128 + dg * 32;
#pragma unroll
        for (int i = 0; i < 4; ++i) { kn[i] = *(const u32x4*)(kp + i * 8); qn[i] = *(const u32x4*)(qp + i * 8); }
        vn = bf2f(proj[tb * NP + C_BV + ce]); bn = gates[tb * 8 + h]; an = gates[tb * 8 + 4 + h];
    }
    for (int t = 0; t < SEQ; ++t) {
        u32x4 kc[4], qc[4];
#pragma unroll
        for (int i = 0; i < 4; ++i) { kc[i] = kn[i]; qc[i] = qn[i]; }
        const float v3 = vn, beta = bn, alpha = __expf(an);
        {
            const size_t tok = tb + (t + 1 < SEQ ? t + 1 : t);
            const bf16_t* kp = s1 + tok * 1024 + 512 + h * 128 + dg * 32; const bf16_t* qp = s1 + tok * 1024 + h * 128 + dg * 32;
#pragma unroll
            for (int i = 0; i < 4; ++i) { kn[i] = *(const u32x4*)(kp + i * 8); qn[i] = *(const u32x4*)(qp + i * 8); }
            vn = bf2f(proj[tok * NP + C_BV + ce]); bn = gates[tok * 8 + h]; an = gates[tok * 8 + 4 + h];
        }
        const float vt = silu(w0 * v0 + w1 * v1 + w2 * v2 + w3 * v3);
        v0 = v1; v1 = v2; v2 = v3;
        float kf[32], qf[32];
#pragma unroll
        for (int i = 0; i < 4; ++i) {
            kf[i * 8 + 0] = lo_bf(kc[i].x); kf[i * 8 + 1] = hi_bf(kc[i].x); kf[i * 8 + 2] = lo_bf(kc[i].y); kf[i * 8 + 3] = hi_bf(kc[i].y);
            kf[i * 8 + 4] = lo_bf(kc[i].z); kf[i * 8 + 5] = hi_bf(kc[i].z); kf[i * 8 + 6] = lo_bf(kc[i].w); kf[i * 8 + 7] = hi_bf(kc[i].w);
            qf[i * 8 + 0] = lo_bf(qc[i].x); qf[i * 8 + 1] = hi_bf(qc[i].x); qf[i * 8 + 2] = lo_bf(qc[i].y); qf[i * 8 + 3] = hi_bf(qc[i].y);
            qf[i * 8 + 4] = lo_bf(qc[i].z); qf[i * 8 + 5] = hi_bf(qc[i].z); qf[i * 8 + 6] = lo_bf(qc[i].w); qf[i * 8 + 7] = hi_bf(qc[i].w);
        }
        float k0 = 0.f, k1 = 0.f, k2 = 0.f, k3 = 0.f;
#pragma unroll
        for (int i = 0; i < 32; i += 4) { k0 += kf[i] * S[i]; k1 += kf[i + 1] * S[i + 1]; k2 += kf[i + 2] * S[i + 2]; k3 += kf[i + 3] * S[i + 3]; }
        float ks = (k0 + k1) + (k2 + k3);
        ks += __shfl_xor(ks, 16); ks += __shfl_xor(ks, 32);
        const float c = beta * (vt - alpha * ks);
        float o0 = 0.f, o1 = 0.f, o2 = 0.f, o3 = 0.f;
#pragma unroll
        for (int i = 0; i < 32; i += 4) {
            S[i] = alpha * S[i] + kf[i] * c; o0 += qf[i] * S[i];
            S[i + 1] = alpha * S[i + 1] + kf[i + 1] * c; o1 += qf[i + 1] * S[i + 1];
            S[i + 2] = alpha * S[i + 2] + kf[i + 2] * c; o2 += qf[i + 2] * S[i + 2];
            S[i + 3] = alpha * S[i + 3] + kf[i + 3] * c; o3 += qf[i + 3] * S[i + 3];
        }
        float o = (o0 + o1) + (o2 + o3);
        o += __shfl_xor(o, 16); o += __shfl_xor(o, 32);
        if (dg == 0) mix[(tb + t) * 1024 + 256 + ce] = f2bf(o);
    }
}
__device__ __forceinline__ f32x4 mma16(const bf16_t* A, int lda, const bf16_t* B, int ldb, int ksteps, f32x4 acc, int fr, int fq) {
    for (int ks = 0; ks < ksteps; ++ks) {
        const pg8::bf16x8 a = *(const pg8::bf16x8*)(A + fr * lda + ks * 32 + fq * 8), b = *(const pg8::bf16x8*)(B + fr * ldb + ks * 32 + fq * 8);
        acc = __builtin_amdgcn_mfma_f32_16x16x32_bf16(a, b, acc, 0, 0, 0);
    }
    return acc;
}
__device__ __forceinline__ uint2 pack4(float a, float b, float c, float d) { uint2 w; w.x = (unsigned)f2bf(a) | ((unsigned)f2bf(b) << 16); w.y = (unsigned)f2bf(c) | ((unsigned)f2bf(d) << 16); return w; }

constexpr int L_WT = 0, L_XCB = 8 * 64 * 72 * 2, L_XLD = 264, L_ZS = L_XCB + 64 * L_XLD * 2;
__device__ void lru_load_wt(const Params& p, int l, unsigned char* smem) {
    const int tid = TID(); bf16_t* wt = (bf16_t*)(smem + L_WT);
    __syncthreads();
#pragma unroll
    for (int i = 0; i < 8; ++i) {
        const int item = tid + 512 * i, g = item >> 9, d = (item >> 3) & 63, e8 = (item & 7) * 8;
        const float* src = p.in[(g >> 2) ? I_LWX : I_LWA] + (size_t)l * 4 * 64 * 64 + (size_t)(g & 3) * 64 * 64 + d * 64 + e8;
        const f32x4 a = *(const f32x4*)src, bq = *(const f32x4*)(src + 4);
        bf16_t* dst = wt + g * 4608 + e8 * 72 + d;
        dst[0] = f2bf(a[0]); dst[72] = f2bf(a[1]); dst[144] = f2bf(a[2]); dst[216] = f2bf(a[3]); dst[288] = f2bf(bq[0]); dst[360] = f2bf(bq[1]); dst[432] = f2bf(bq[2]); dst[504] = f2bf(bq[3]);
    }
    __syncthreads();
}
__device__ void lru_unit_a(const Params& p, int l, int unit, unsigned char* smem) {
    const int tid = TID(), lane = tid & 63, wv = tid >> 6, fr = lane & 15, fq = lane >> 4;
    const bf16_t* wt = (const bf16_t*)(smem + L_WT); bf16_t* xcb = (bf16_t*)(smem + L_XCB); bf16_t* zs = (bf16_t*)(smem + L_ZS);
    const bf16_t* proj = (const bf16_t*)(p.ws + WS_R); bf16_t* Z = (bf16_t*)(p.ws + WS_Z);
    const size_t tok0 = (size_t)unit * 64; const int pos0 = (unit & 127) * 64;
    const float* lcw = p.in[I_LCW] + (size_t)l * 4 * 256; const float* lcb = p.in[I_LCB] + l * 256;
    __syncthreads();
    {
        const int c = tid & 255, th = tid >> 8;
        const float w0 = lcw[c], w1 = lcw[256 + c], w2 = lcw[512 + c], w3 = lcw[768 + c], cb = lcb[c];
        const int tk0 = th * 32;
        float x0 = 0.f, x1 = 0.f, x2 = 0.f;
        if (pos0 + tk0 > 0) { const bf16_t* q = proj + (tok0 + tk0 - 3) * NP + C_CX + c; x0 = bf2f(q[0]); x1 = bf2f(q[NP]); x2 = bf2f(q[2 * NP]); }
        bf16_t xin[32];
#pragma unroll
        for (int i = 0; i < 32; ++i) xin[i] = proj[(tok0 + tk0 + i) * NP + C_CX + c];
#pragma unroll
        for (int tk = tk0; tk < tk0 + 32; ++tk) {
            const float x3 = bf2f(xin[tk - tk0]);
            xcb[tk * L_XLD + c] = f2bf(w0 * x0 + w1 * x1 + w2 * x2 + w3 * x3 + cb);
            x0 = x1; x1 = x2; x2 = x3;
        }
    }
    __syncthreads();
    const int c = tid & 255;
    const float sp = softplus(-p.in[I_LLAM][l * 256 + c]);
    float P = 1.f, H = 0.f;
    for (int q = 0; q < 4; ++q) {
#pragma unroll
        for (int i = 0; i < 4; ++i) {
            const int id = wv * 4 + i, g = id >> 2, et = id & 3, gate = g >> 2, n = g & 3;
            const f32x4 acc = mma16(wt + g * 4608 + et * 16 * 72, 72, xcb + (q * 16) * L_XLD + n * 64, L_XLD, 2, (f32x4){0.f, 0.f, 0.f, 0.f}, fr, fq);
            const int e0 = et * 16 + fq * 4;
            const f32x4 bv = *(const f32x4*)(p.in[gate ? I_LBX : I_LBA] + l * 256 + n * 64 + e0);
            const uint2 zb = pack4(acc[0] + bv[0], acc[1] + bv[1], acc[2] + bv[2], acc[3] + bv[3]);
            *(uint2*)(zs + fr * 512 + gate * 256 + n * 64 + e0) = zb;
            *(uint2*)(Z + (tok0 + q * 16 + fr) * 512 + gate * 256 + n * 64 + e0) = zb;
        }
        __syncthreads();
        if (tid < 256) {
#pragma unroll
            for (int j = 0; j < 16; ++j) {
                const int tk = q * 16 + j;
                const float r = sigm(bf2f(zs[j * 512 + c])), ig = sigm(bf2f(zs[j * 512 + 256 + c]));
                const float log_a = -8.f * r * sp, a = __expf(log_a);
                const float mult = (pos0 + tk == 0) ? 1.f : sqrtf(fmaxf(-expm1f(2.f * log_a), EPS));
                H = a * H + mult * ig * bf2f(xcb[tk * L_XLD + c]); P *= a;
            }
        }
        __syncthreads();
    }
    if (tid < 256) ((float2*)(p.ws + WS_LAGG))[(size_t)unit * 256 + c] = make_float2(P, H);
}
__device__ void lru_carry(const Params& p, int gt  ) {
    const int b = gt >> 8, c = gt & 255;
    const float2* agg = (const float2*)(p.ws + WS_LAGG); float* car = (float*)(p.ws + WS_LCAR);
    float h = 0.f;
    for (int n0 = 0; n0 < 128; n0 += 8) {
        float2 a[8];
#pragma unroll
        for (int j = 0; j < 8; ++j) a[j] = agg[(size_t)(b * 128 + n0 + j) * 256 + c];
#pragma unroll
        for (int j = 0; j < 8; ++j) { car[(size_t)(b * 128 + n0 + j) * 256 + c] = h; h = a[j].x * h + a[j].y; }
    }
}
__device__ void lru_unit_c(const Params& p, int l, int unit, int c) {
    const bf16_t* proj = (const bf16_t*)(p.ws + WS_R); const bf16_t* Z = (const bf16_t*)(p.ws + WS_Z); bf16_t* mix = (bf16_t*)(p.ws + WS_MIX);
    const size_t tok0 = (size_t)unit * 64; const int pos0 = (unit & 127) * 64;
    const float* lcw = p.in[I_LCW] + (size_t)l * 4 * 256;
    const float w0 = lcw[c], w1 = lcw[256 + c], w2 = lcw[512 + c], w3 = lcw[768 + c], cb = p.in[I_LCB][l * 256 + c];
    const float sp = softplus(-p.in[I_LLAM][l * 256 + c]);
    float h = ((const float*)(p.ws + WS_LCAR))[(size_t)unit * 256 + c];
    float x0 = 0.f, x1 = 0.f, x2 = 0.f;
    if (pos0 > 0) { const bf16_t* q = proj + (tok0 - 3) * NP + C_CX + c; x0 = bf2f(q[0]); x1 = bf2f(q[NP]); x2 = bf2f(q[2 * NP]); }
    for (int g = 0; g < 8; ++g) {
        float zr[8], zi[8], xs[8], ys[8];
#pragma unroll
        for (int j = 0; j < 8; ++j) {
            const size_t tok = tok0 + g * 8 + j;
            zr[j] = bf2f(Z[tok * 512 + c]); zi[j] = bf2f(Z[tok * 512 + 256 + c]); xs[j] = bf2f(proj[tok * NP + C_CX + c]); ys[j] = bf2f(proj[tok * NP + C_CY + c]);
        }
        float o[8];
#pragma unroll
        for (int j = 0; j < 8; ++j) {
            const int tk = g * 8 + j;
            const float xcv = bf2f(f2bf(w0 * x0 + w1 * x1 + w2 * x2 + w3 * xs[j] + cb));
            x0 = x1; x1 = x2; x2 = xs[j];
            const float r = sigm(zr[j]), ig = sigm(zi[j]);
            const float log_a = -8.f * r * sp, a = __expf(log_a);
            const float mult = (pos0 + tk == 0) ? 1.f : sqrtf(fmaxf(-expm1f(2.f * log_a), EPS));
            h = a * h + mult * ig * xcv;
            o[j] = gelu_tanh(ys[j]) * h;
        }
#pragma unroll
        for (int j = 0; j < 8; ++j) mix[(tok0 + g * 8 + j) * 1024 + 768 + c] = f2bf(o[j]);
    }
}

constexpr int HT_LD = 72, HT_BYTES = 64 * HT_LD * 2, H_CUM_BYTES = 64 * 65 * 4;
__device__ __forceinline__ void hgrn_load(const Params& p, int unit, int tid, u32x4 (&pf)[3]) {
    const bf16_t* pr = (const bf16_t*)(p.ws + WS_R) + ((size_t)(unit >> 2) * 64 + (tid >> 3)) * NP + (unit & 3) * 64 + (tid & 7) * 8;
    pf[0] = *(const u32x4*)(pr + C_AQ); pf[1] = *(const u32x4*)(pr + C_AF); pf[2] = *(const u32x4*)(pr + C_AI);
}
template <bool OUT> __device__ void hgrn_unit(const Params& p, int l, int unit, int next_unit, u32x4 (&pf)[3], unsigned char* smem, const float* lbs  ) {
    const int tid = TID(), lane = tid & 63, wv = tid >> 6, fr = lane & 15, fq = lane >> 4;
    const int h = unit & 3; const size_t tok0 = (size_t)(unit >> 2) * 64;
    const bf16_t* proj = (const bf16_t*)(p.ws + WS_R);
    float* cum = (float*)smem;
    bf16_t* tA = (bf16_t*)(smem + H_CUM_BYTES);
    bf16_t* tV = tA + 64 * HT_LD;
    bf16_t* tQ = tV + 64 * HT_LD;
    bf16_t* tD = tQ + 64 * HT_LD;
    bf16_t* tP = tD + 64 * HT_LD;
    bf16_t* tS = tP + 64 * HT_LD;
    float* sqx = (float*)(tS + 64 * HT_LD);

#ifdef HGRN_PROBE_U
    bf16_t* hs = (bf16_t*)(p.ws + WS_HS) + (size_t)unit * 4096;
#else
    bf16_t* hs = (bf16_t*)(p.ws + (OUT ? WS_HS2 : WS_HS)) + (size_t)unit * 4096;
#endif
    const int t = tid >> 3, d0 = (tid & 7) * 8;
    const u32x4 raq = pf[0], raf = pf[1], rai = pf[2];
    if (next_unit < 2048) hgrn_load(p, next_unit, tid, pf);
    const float aq[8] = {lo_bf(raq.x), hi_bf(raq.x), lo_bf(raq.y), hi_bf(raq.y), lo_bf(raq.z), hi_bf(raq.z), lo_bf(raq.w), hi_bf(raq.w)};
    const float af[8] = {lo_bf(raf.x), hi_bf(raf.x), lo_bf(raf.y), hi_bf(raf.y), lo_bf(raf.z), hi_bf(raf.z), lo_bf(raf.w), hi_bf(raf.w)};
    const float vv[8] = {lo_bf(rai.x), hi_bf(rai.x), lo_bf(rai.y), hi_bf(rai.y), lo_bf(rai.z), hi_bf(rai.z), lo_bf(rai.w), hi_bf(rai.w)};
    float q[8], kk[8];
    __syncthreads();
#pragma unroll
    for (int j = 0; j < 8; ++j) {
        const float lb = lbs[h * 64 + d0 + j];
        const float ex = __expf(-fminf(fmaxf(af[j], -80.f), 80.f)), sg = 1.f / (1.f + ex);
        const float f = fmaxf(lb + (1.f - lb) * sg, 1e-30f);
        kk[j] = (1.f - lb) * (ex * sg);
        q[j] = aq[j] / (1.f + __expf(-aq[j]));
        cum[t * 65 + d0 + j] = __logf(f);
    }
    __syncthreads();
    if (tid < 64) { float run = 0.f;
#pragma unroll 8
        for (int s = 0; s < 64; ++s) { run += cum[s * 65 + tid]; cum[s * 65 + tid] = run; } }
    __syncthreads();
    if (!OUT) {
#pragma unroll
        for (int j = 0; j < 8; ++j) {
            const float cl = cum[63 * 65 + d0 + j], c = cum[t * 65 + d0 + j];
            tA[(d0 + j) * HT_LD + t] = f2bf(kk[j] * __expf(cl - c));
            tV[(d0 + j) * HT_LD + t] = f2bf(vv[j]);
            if (t == 0) ((float*)(p.ws + WS_HCD))[(size_t)unit * 64 + d0 + j] = __expf(cl);
        }
        __syncthreads();
#pragma unroll
        for (int i = 0; i < 2; ++i) {
            const int tile = wv * 2 + i, dt = tile >> 2, et = tile & 3;
            const f32x4 acc = mma16(tA + dt * 16 * HT_LD, HT_LD, tV + et * 16 * HT_LD, HT_LD, 2, (f32x4){0.f, 0.f, 0.f, 0.f}, fr, fq);
            *(uint2*)(hs + (et * 16 + fr) * 64 + dt * 16 + fq * 4) = pack4(acc[0], acc[1], acc[2], acc[3]);
        }
    } else {
        float qt[8], kt[8], qd[8];
#pragma unroll
        for (int j = 0; j < 8; ++j) {
            const float cr = cum[31 * 65 + d0 + j], c = cum[t * 65 + d0 + j];
            qt[j] = q[j] * __expf(fminf(c - cr, 80.f)); kt[j] = kk[j] * __expf(fminf(cr - c, 80.f)); qd[j] = q[j] * __expf(c);
            tV[(d0 + j) * HT_LD + t] = f2bf(vv[j]);
        }
        { u32x4 w; w.x = cvt_pk_bf16(qt[0], qt[1]); w.y = cvt_pk_bf16(qt[2], qt[3]); w.z = cvt_pk_bf16(qt[4], qt[5]); w.w = cvt_pk_bf16(qt[6], qt[7]); *(u32x4*)(tQ + t * HT_LD + d0) = w; }
        { u32x4 w; w.x = cvt_pk_bf16(kt[0], kt[1]); w.y = cvt_pk_bf16(kt[2], kt[3]); w.z = cvt_pk_bf16(kt[4], kt[5]); w.w = cvt_pk_bf16(kt[6], kt[7]); *(u32x4*)(tA + t * HT_LD + d0) = w; }
        *(u32x4*)(tS + t * HT_LD + d0) = *(const u32x4*)(hs + t * 64 + d0);
        { u32x4 w; w.x = cvt_pk_bf16(qd[0], qd[1]); w.y = cvt_pk_bf16(qd[2], qd[3]); w.z = cvt_pk_bf16(qd[4], qd[5]); w.w = cvt_pk_bf16(qd[6], qd[7]); *(u32x4*)(tD + t * HT_LD + d0) = w; }
        __syncthreads();
#pragma unroll
        for (int i = 0; i < 2; ++i) {
            const int tile = wv * 2 + i, si = tile >> 2, tj = tile & 3;
            f32x4 acc = {0.f, 0.f, 0.f, 0.f};
            if (si <= tj) acc = mma16(tA + si * 16 * HT_LD, HT_LD, tQ + tj * 16 * HT_LD, HT_LD, 2, acc, fr, fq);
            const int tt = tj * 16 + fr, s0 = si * 16 + fq * 4;
            *(uint2*)(tP + tt * HT_LD + s0) = pack4(s0 <= tt ? acc[0] : 0.f, s0 + 1 <= tt ? acc[1] : 0.f, s0 + 2 <= tt ? acc[2] : 0.f, s0 + 3 <= tt ? acc[3] : 0.f);
        }
        __syncthreads();
        {
            const int tj = wv & 3, eh = wv >> 2, tt = tj * 16 + fr;
            f32x4 o[2]; float ssq = 0.f;
#pragma unroll
            for (int i = 0; i < 2; ++i) {
                const int et = eh * 2 + i;
                f32x4 acc = mma16(tV + et * 16 * HT_LD, HT_LD, tP + tj * 16 * HT_LD, HT_LD, 2, (f32x4){0.f, 0.f, 0.f, 0.f}, fr, fq);
                acc = mma16(tS + et * 16 * HT_LD, HT_LD, tD + tj * 16 * HT_LD, HT_LD, 2, acc, fr, fq);
                o[i] = acc; ssq += acc[0] * acc[0] + acc[1] * acc[1] + acc[2] * acc[2] + acc[3] * acc[3];
            }
            ssq += __shfl_xor(ssq, 16); ssq += __shfl_xor(ssq, 32);
            if (fq == 0) sqx[eh * 64 + tt] = ssq;
            __syncthreads();
            const float r = rsqrtf((sqx[tt] + sqx[64 + tt]) * (1.f / 64.f) + EPS);
            const float* g = p.in[I_HNG] + l * 64; bf16_t* mix = (bf16_t*)(p.ws + WS_MIX);
#pragma unroll
            for (int i = 0; i < 2; ++i) {
                const int e = (eh * 2 + i) * 16 + fq * 4;
                const uint2 gz = *(const uint2*)(proj + (tok0 + tt) * NP + C_AG + h * 64 + e);
                const f32x4 gv = *(const f32x4*)(g + e);
                *(uint2*)(mix + (tok0 + tt) * 1024 + h * 64 + e) = pack4(o[i][0] * r * gv[0] * silu(lo_bf(gz.x)), o[i][1] * r * gv[1] * silu(hi_bf(gz.x)),
                                                                          o[i][2] * r * gv[2] * silu(lo_bf(gz.y)), o[i][3] * r * gv[3] * silu(hi_bf(gz.y)));
            }
        }
    }
}
__device__ void hgrn_scan(const Params& p, int gt  ) {
    const int bh = gt >> 10, e = (gt >> 4) & 63, d4 = (gt & 15) * 4, b = bh >> 2, h = bh & 3;
    const bf16_t* hs = (const bf16_t*)(p.ws + WS_HS); bf16_t* hs2 = (bf16_t*)(p.ws + WS_HS2); const float* cdb = (const float*)(p.ws + WS_HCD);
    float S[4] = {0.f, 0.f, 0.f, 0.f};
    uint2 u[4], un[4]; f32x4 cd[4], cdn[4];
#pragma unroll
    for (int j = 0; j < 4; ++j) { const size_t unit = (size_t)(b * 128 + j) * 4 + h; u[j] = *(const uint2*)(hs + unit * 4096 + e * 64 + d4); cd[j] = *(const f32x4*)(cdb + unit * 64 + d4); }
    for (int n0 = 0; n0 < 128; n0 += 4) {
        if (n0 + 4 < 128) {
#pragma unroll
            for (int j = 0; j < 4; ++j) { const size_t unit = (size_t)(b * 128 + n0 + 4 + j) * 4 + h; un[j] = *(const uint2*)(hs + unit * 4096 + e * 64 + d4); cdn[j] = *(const f32x4*)(cdb + unit * 64 + d4); }
        }
#pragma unroll
        for (int j = 0; j < 4; ++j) {
            const size_t unit = (size_t)(b * 128 + n0 + j) * 4 + h;
            *(uint2*)(hs2 + unit * 4096 + e * 64 + d4) = pack4(S[0], S[1], S[2], S[3]);
            S[0] = cd[j][0] * S[0] + lo_bf(u[j].x); S[1] = cd[j][1] * S[1] + hi_bf(u[j].x); S[2] = cd[j][2] * S[2] + lo_bf(u[j].y); S[3] = cd[j][3] * S[3] + hi_bf(u[j].y);
        }
#pragma unroll
        for (int j = 0; j < 4; ++j) { u[j] = un[j]; cd[j] = cdn[j]; }
    }
}

constexpr int G_TMP = 0, G_VF = 32768, G_QB = 65536, G_LDB = 136, G_KB = G_QB + 64 * G_LDB * 2, G_AS = G_KB + 64 * G_LDB * 2, G_LDA = 68, G_SC = G_AS + 64 * G_LDA * 4;
__device__ __forceinline__ int frag_off(int r, int k, int KS) { return ((r >> 4) * KS + (k >> 5)) * 512 + ((((k >> 3) & 3) * 16 + (r & 15)) << 3) + (k & 7); }
__device__ __forceinline__ void gdn_raw_load(const bf16_t* proj, int unit, int sect, int tid, u32x4 (&v)[3]) {
    const int h = unit & 3, n = (unit >> 2) & 127; const size_t tok0 = (size_t)(unit >> 2) * 64; const int pcol0 = C_BQ + sect * 512 + h * 128;
#pragma unroll
    for (int i = 0; i < 3; ++i) {
        const int idx = tid + 512 * i, r = idx >> 4, c8 = (idx & 15) * 8;
        v[i] = (u32x4){0u, 0u, 0u, 0u};
        if (idx < 67 * 16 && (n > 0 || r >= 3)) v[i] = *(const u32x4*)(proj + (tok0 + r - 3) * NP + pcol0 + c8);
    }
}
__device__ __forceinline__ void gdn_raw_store(bf16_t* raw, int tid, const u32x4 (&v)[3]) {
#pragma unroll
    for (int i = 0; i < 3; ++i) { const int idx = tid + 512 * i; if (idx < 67 * 16) *(u32x4*)(raw + (idx >> 4) * 128 + (idx & 15) * 8) = v[i]; }
}
__device__ __forceinline__ void gdn_conv16(const Params& p, int l, const bf16_t* raw, int wch, int rg, int c, float* out) {
    const float* cw = p.in[I_GCW] + (size_t)l * 4 * 1536 + wch;
    const float w0 = cw[0], w1 = cw[1536], w2 = cw[3072], w3 = cw[4608];
    const int t0 = rg * 16; const bf16_t* q = raw + t0 * 128 + c;
    float x0 = bf2f(q[0]), x1 = bf2f(q[128]), x2 = bf2f(q[256]);
#pragma unroll
    for (int i = 0; i < 16; ++i) {
        const float x3 = bf2f(q[(i + 3) * 128]);
        out[(t0 + i) * 128 + c] = silu(w0 * x0 + w1 * x1 + w2 * x2 + w3 * x3);
        x0 = x1; x1 = x2; x2 = x3;
    }
}
#ifndef PROBE_DUP
#define PROBE_DUP 0
#endif
#ifndef PROBE_SKIP
#define PROBE_SKIP 0
#endif
__device__ void gdn_unit_m1(const Params& p, int l, int unit, int next_unit, u32x4 (&pq)[3], u32x4 (&pk)[3], u32x4 (&pv)[3], unsigned char* smem, bool fin = true) {
    const int skip = fin ? 0 : PROBE_SKIP;
    const int tid = TID(), lane = tid & 63, wv = tid >> 6, fr = lane & 15, fq = lane >> 4;
    const int h = unit & 3, n = (unit >> 2) & 127; const size_t tok0 = (size_t)(unit >> 2) * 64;
    float* tmp = (float*)(smem + G_TMP); float* vf = (float*)(smem + G_VF);
    bf16_t* qb = (bf16_t*)(smem + G_QB); bf16_t* kb = (bf16_t*)(smem + G_KB);
    float* As = (float*)(smem + G_AS); float* gcs = (float*)(smem + G_SC); float* bts = gcs + 64; float* egc = gcs + 128;
    const bf16_t* proj = (const bf16_t*)(p.ws + WS_R); float* gates = (float*)(p.ws + WS_GATES);
    bf16_t* uw = (bf16_t*)(p.ws + WS_XB) + (size_t)unit * 16384; bf16_t* qk1 = (bf16_t*)(p.ws + WS_S1) + (size_t)unit * 16384; bf16_t* qko = (bf16_t*)(p.ws + WS_QK) + (size_t)unit * 4096;
    const int c = tid & 127, rg = tid >> 7;
    __syncthreads();
    gdn_raw_store(qb, tid, pq); gdn_raw_store(kb, tid, pk); gdn_raw_store((bf16_t*)As, tid, pv);
    if (tid < 64) {
        float la = gates[(tok0 + tid) * 8 + 4 + h];
#pragma unroll
        for (int o = 1; o < 64; o <<= 1) { const float v = __shfl_up(la, o); if (lane >= o) la += v; }
        gcs[tid] = la; egc[tid] = __expf(la); bts[tid] = gates[(tok0 + tid) * 8 + h];
    }
    __syncthreads();
    gdn_conv16(p, l, qb, h * 128 + c, rg, c, tmp);
    gdn_conv16(p, l, kb, 512 + h * 128 + c, rg, c, vf);
    __syncthreads();
#pragma unroll
    for (int i = 0; i < 8; ++i) {
        const int t = wv * 8 + i; const float2 v = *(const float2*)(tmp + t * 128 + 2 * lane), v2 = *(const float2*)(vf + t * 128 + 2 * lane);
        const float r = rsqrtf(wave_sum(v.x * v.x + v.y * v.y) + EPS) * 0.08838834764831845f, r2 = rsqrtf(wave_sum(v2.x * v2.x + v2.y * v2.y) + EPS);
        *(unsigned*)(qb + t * G_LDB + 2 * lane) = (unsigned)f2bf(v.x * r) | ((unsigned)f2bf(v.y * r) << 16);
        *(unsigned*)(kb + t * G_LDB + 2 * lane) = (unsigned)f2bf(v2.x * r2) | ((unsigned)f2bf(v2.y * r2) << 16);
    }
    __syncthreads();
    gdn_conv16(p, l, (const bf16_t*)As, 1024 + h * 128 + c, rg, c, vf);
    __syncthreads();
#pragma unroll
    for (int i = 0; i < 4; ++i) {
        const int id = wv * 4 + i, kind = id >> 4, tile = id & 15, si = tile >> 2, tj = tile & 3;
        const int t = tj * 16 + fr, s0 = si * 16 + fq * 4;
        if (si <= tj) {
            const f32x4 acc = mma16(kb + si * 16 * G_LDB, G_LDB, (kind ? qb : kb) + tj * 16 * G_LDB, G_LDB, 4, (f32x4){0.f, 0.f, 0.f, 0.f}, fr, fq);
            const float gt = gcs[t]; const f32x4 gs = *(const f32x4*)(gcs + s0);
            float v[4];
#pragma unroll
            for (int j = 0; j < 4; ++j) v[j] = acc[j] * __expf(fminf(gt - gs[j], 0.f));
            if (kind == 0) { const float bt = bts[t];
                *(f32x4*)(As + t * G_LDA + s0) = (f32x4){s0 < t ? bt * v[0] : 0.f, s0 + 1 < t ? bt * v[1] : 0.f, s0 + 2 < t ? bt * v[2] : 0.f, s0 + 3 < t ? bt * v[3] : 0.f};
            } else *(uint2*)(qko + frag_off(t, s0, 2)) = pack4(s0 <= t ? v[0] : 0.f, s0 + 1 <= t ? v[1] : 0.f, s0 + 2 <= t ? v[2] : 0.f, s0 + 3 <= t ? v[3] : 0.f);
        } else if (kind == 1) *(uint2*)(qko + frag_off(t, s0, 2)) = make_uint2(0u, 0u);
    }
    __syncthreads();
    const float gcl = gcs[63];
    if (next_unit < 2048) { gdn_raw_load(proj, next_unit, 0, tid, pq); gdn_raw_load(proj, next_unit, 1, tid, pk); gdn_raw_load(proj, next_unit, 2, tid, pv); }
    if (tid >= 256) {
        const int tt = tid - 256;
        { const int t = tt >> 2, d0 = (tt & 3) * 32; const float eg = egc[t];
#pragma unroll
          for (int g = 0; g < 4; ++g) { const u32x4 qv = *(const u32x4*)(qb + t * G_LDB + d0 + g * 8); u32x4 w;
              const uint2 lo = pack4(lo_bf(qv.x) * eg, hi_bf(qv.x) * eg, lo_bf(qv.y) * eg, hi_bf(qv.y) * eg), hi = pack4(lo_bf(qv.z) * eg, hi_bf(qv.z) * eg, lo_bf(qv.w) * eg, hi_bf(qv.w) * eg);
              w.x = lo.x; w.y = lo.y; w.z = hi.x; w.w = hi.y; *(u32x4*)(qk1 + frag_off(t, d0 + g * 8, 4)) = w; } }
        { const int d = tt >> 1, sh = (tt & 1) * 32;
#pragma unroll
          for (int g = 0; g < 4; ++g) { float v[8];
#pragma unroll
              for (int j = 0; j < 8; ++j) { const int s = sh + g * 8 + j; v[j] = bf2f(kb[s * G_LDB + d]) * __expf(gcl - gcs[s]); }
              u32x4 w; const uint2 lo = pack4(v[0], v[1], v[2], v[3]), hi = pack4(v[4], v[5], v[6], v[7]);
              w.x = lo.x; w.y = lo.y; w.z = hi.x; w.w = hi.y; *(u32x4*)(qk1 + 8192 + frag_off(d, sh + g * 8, 2)) = w; } }
        if (tt == 0 && fin) gates[tok0 * 8 + 4 + h] = gcl;
    }
    if (!(skip & 1)) {
#pragma unroll 1
        for (int I = 0; I < 4; ++I) {
            float ad[4][16];
#pragma unroll
            for (int jj = 0; jj < 4; ++jj)
#pragma unroll
                for (int s4 = 0; s4 < 4; ++s4) { const f32x4 a = *(const f32x4*)(As + (I * 16 + fq * 4 + jj) * G_LDA + I * 16 + s4 * 4); ad[jj][s4 * 4] = a[0]; ad[jj][s4 * 4 + 1] = a[1]; ad[jj][s4 * 4 + 2] = a[2]; ad[jj][s4 * 4 + 3] = a[3]; }
            float x[2][4]; float* X[2];
#pragma unroll
            for (int c2 = 0; c2 < 2; ++c2) {
                const int col = (wv * 2 + c2) * 16 + fr;
                X[c2] = (col < 128 ? vf : tmp) + (col & 127);
                f32x4 acc = {0.f, 0.f, 0.f, 0.f};
                for (int J = 0; J < I; ++J)
#pragma unroll
                    for (int kk = 0; kk < 4; ++kk)
                        acc = __builtin_amdgcn_mfma_f32_16x16x4f32(As[(I * 16 + fr) * G_LDA + J * 16 + kk * 4 + fq], X[c2][(J * 16 + kk * 4 + fq) * 128], acc, 0, 0, 0);
#pragma unroll
                for (int jj = 0; jj < 4; ++jj) { const int t = I * 16 + fq * 4 + jj;
                    const float rhs = (col < 128) ? bts[t] * X[c2][t * 128] : bts[t] * egc[t] * bf2f(kb[t * G_LDB + (col & 127)]);
                    x[c2][jj] = rhs - acc[jj]; }
            }
#pragma unroll
            for (int r = 0; r < 16; ++r) {
                const float xr0 = __shfl(x[0][r & 3], (r >> 2) * 16 + fr), xr1 = __shfl(x[1][r & 3], (r >> 2) * 16 + fr);
#pragma unroll
                for (int jj = 0; jj < 4; ++jj) { x[0][jj] -= ad[jj][r] * xr0; x[1][jj] -= ad[jj][r] * xr1; }
            }
#pragma unroll
            for (int c2 = 0; c2 < 2; ++c2)
#pragma unroll
                for (int jj = 0; jj < 4; ++jj) X[c2][(I * 16 + fq * 4 + jj) * 128] = x[c2][jj];
        }
    }
    __syncthreads();
#pragma unroll
    for (int i = 0; i < 2; ++i) {
        const int pc = tid + 512 * i, blk = pc >> 6, ln = pc & 63, t = (blk >> 2) * 16 + (ln & 15), k0 = (blk & 3) * 32 + (ln >> 4) * 8;
        const f32x4 a = *(const f32x4*)(tmp + t * 128 + k0), bq = *(const f32x4*)(tmp + t * 128 + k0 + 4);
        u32x4 w; const uint2 lo = pack4(a[0], a[1], a[2], a[3]), hi = pack4(bq[0], bq[1], bq[2], bq[3]); w.x = lo.x; w.y = lo.y; w.z = hi.x; w.w = hi.y;
        *(u32x4*)(uw + 8192 + pc * 8) = w;
    }
#pragma unroll
    for (int i = 0; i < 4; ++i) {
        const int pc = tid + 512 * i, blk = pc >> 6, ln = pc & 63, e = (blk >> 2) * 16 + (ln & 15), t0 = (blk & 3) * 16 + (ln >> 4) * 4;
        *(uint2*)(uw + pc * 4) = pack4(vf[t0 * 128 + e], vf[(t0 + 1) * 128 + e], vf[(t0 + 2) * 128 + e], vf[(t0 + 3) * 128 + e]);
    }
}
template <int DRY> __device__ void gdn_seq(const Params& p, int l, int item, unsigned char* smem) {
    const int tid = TID(), lane = tid & 63, wv = tid >> 6, fr = lane & 15, fq = lane >> 4;
    const int b = item >> 5, h = (item >> 3) & 3, es = item & 7, tt = wv & 3; const bool isq = wv >= 4;
    bf16_t* Sl = (bf16_t*)smem;
    bf16_t* Vn = (bf16_t*)(smem + 4352);
    bf16_t* Ot = (bf16_t*)(smem + 6656);
    const bf16_t* UW = (const bf16_t*)(p.ws + WS_XB); const bf16_t* QKD = (const bf16_t*)(p.ws + WS_S1); const bf16_t* QKB = (const bf16_t*)(p.ws + WS_QK);
    const float* gates = (const float*)(p.ws + WS_GATES); bf16_t* mix = (bf16_t*)(p.ws + WS_MIX);
    const int zoff = tid >> 20;
    __syncthreads();
    for (int i = tid; i < 16 * 136 / 2; i += 512) ((unsigned*)Sl)[i] = 0u;
    __syncthreads();
    f32x4 S = {0.f, 0.f, 0.f, 0.f};
    pg8::bf16x8 A4[4][4], K2[4][2], Q2[4][2]; uint2 UU[4]; float GL[4];
#define GDN_LOAD(nn, J) do { const size_t cu = (size_t)((b * 128 + (nn)) * 4 + h); \
        const bf16_t* ap = (isq ? QKD + cu * 16384 : UW + cu * 16384 + 8192) + tt * 2048 + lane * 8; \
        _Pragma("unroll") for (int ks = 0; ks < 4; ++ks) A4[J][ks] = *(const pg8::bf16x8*)(ap + ks * 512); \
        const bf16_t* kp = QKD + cu * 16384 + 8192 + wv * 1024 + lane * 8; K2[J][0] = *(const pg8::bf16x8*)kp; K2[J][1] = *(const pg8::bf16x8*)(kp + 512); \
        if (isq) { const bf16_t* qp = QKB + cu * 4096 + tt * 1024 + lane * 8; Q2[J][0] = *(const pg8::bf16x8*)qp; Q2[J][1] = *(const pg8::bf16x8*)(qp + 512); } \
        else UU[J] = *(const uint2*)(UW + cu * 16384 + ((es * 4 + tt) * 64 + lane) * 4); \
        GL[J] = gates[(size_t)(b * 128 + (nn)) * 512 + 4 + h + zoff]; } while (0)
#pragma unroll
    for (int j = 0; j < 4; ++j) GDN_LOAD(j, j);
    for (int n0 = 0; n0 < 128; n0 += 4) {
#pragma unroll
        for (int j = 0; j < 4; ++j) {
            const int n = n0 + j;
            f32x4 acc = {0.f, 0.f, 0.f, 0.f};
#pragma unroll
            for (int ks = 0; ks < 4; ++ks) acc = __builtin_amdgcn_mfma_f32_16x16x32_bf16(A4[j][ks], *(const pg8::bf16x8*)(Sl + fr * 136 + ks * 32 + fq * 8), acc, 0, 0, 0);
            if (!isq) *(uint2*)(Vn + fr * 72 + tt * 16 + fq * 4) = pack4(lo_bf(UU[j].x) - acc[0], hi_bf(UU[j].x) - acc[1], lo_bf(UU[j].y) - acc[2], hi_bf(UU[j].y) - acc[3]);
            __syncthreads();
            const float cd = __expf(GL[j]);
            f32x4 sacc = S * cd;
#pragma unroll
            for (int ks = 0; ks < 2; ++ks) sacc = __builtin_amdgcn_mfma_f32_16x16x32_bf16(K2[j][ks], *(const pg8::bf16x8*)(Vn + fr * 72 + ks * 32 + fq * 8), sacc, 0, 0, 0);
            S = sacc;
            if (isq) {
#pragma unroll
                for (int ks = 0; ks < 2; ++ks) acc = __builtin_amdgcn_mfma_f32_16x16x32_bf16(Q2[j][ks], *(const pg8::bf16x8*)(Vn + fr * 72 + ks * 32 + fq * 8), acc, 0, 0, 0);
                bf16_t* op = Ot + (tt * 16 + fq * 4) * 16 + fr;
                op[0] = f2bf(acc[0]); op[16] = f2bf(acc[1]); op[32] = f2bf(acc[2]); op[48] = f2bf(acc[3]);
            }
            *(uint2*)(Sl + fr * 136 + wv * 16 + fq * 4) = pack4(S[0], S[1], S[2], S[3]);
            __syncthreads();
            if (tid < 128)
                *(u32x4*)(mix + ((size_t)(b * 128 + n) * 64 + es * 8 + (tid >> 4)) * 1024 + 256 + h * 128 + (tid & 15) * 8) = *(const u32x4*)(Ot + tid * 8);
            if (DRY != 1) { const int nx = DRY == 2 ? j : (n + 4 < 128 ? n + 4 : 127); GDN_LOAD(nx, j); }
        }
    }
#undef GDN_LOAD
}

#ifndef HGRN_NAIVE
#define HGRN_NAIVE 0
#endif
#ifndef LRU_NAIVE
#define LRU_NAIVE 0
#endif
__device__ void hgrn_naive(const Params& p, int l, int item) {
    const int lane = TID() & 63, dg = lane >> 4, e = lane & 15;
    const int b = item >> 4, h = (item >> 2) & 3, eg = item & 3, ce = h * 64 + eg * 16 + e;
    const bf16_t* proj = (const bf16_t*)(p.ws + WS_R); bf16_t* mix = (bf16_t*)(p.ws + WS_MIX);
    const float lb = lower_bound(p.in[I_LB], l, h * 64 + lane);
    float S[16];
#pragma unroll
    for (int i = 0; i < 16; ++i) S[i] = 0.f;
    const size_t tb = (size_t)b * SEQ;
    float fpn = bf2f(proj[tb * NP + C_AF + h * 64 + lane]), aqn = bf2f(proj[tb * NP + C_AQ + h * 64 + lane]), vn = bf2f(proj[tb * NP + C_AI + ce]);
    for (int t = 0; t < SEQ; ++t) {
        const float fp = fpn, aq = aqn, v = vn;
        {
            const size_t tok = tb + (t + 1 < SEQ ? t + 1 : t);
            fpn = bf2f(proj[tok * NP + C_AF + h * 64 + lane]); aqn = bf2f(proj[tok * NP + C_AQ + h * 64 + lane]); vn = bf2f(proj[tok * NP + C_AI + ce]);
        }
        const float sg = sigm(fp);
        const float f = fmaxf(lb + (1.f - lb) * sg, 1e-30f), k = (1.f - lb) * sigm(-fp), q = silu(aq);
        float o0 = 0.f, o1 = 0.f;
#pragma unroll
        for (int j = 0; j < 16; j += 2) {
            const int s0 = (lane & 48) | j, s1 = s0 + 1;
            const float f0 = __shfl(f, s0), kk0 = __shfl(k, s0), q0 = __shfl(q, s0), f1 = __shfl(f, s1), kk1 = __shfl(k, s1), q1 = __shfl(q, s1);
            S[j] = f0 * S[j] + kk0 * v; o0 += q0 * S[j];
            S[j + 1] = f1 * S[j + 1] + kk1 * v; o1 += q1 * S[j + 1];
        }
        float o = o0 + o1;
        o += __shfl_xor(o, 16); o += __shfl_xor(o, 32);
        if (dg == 0) mix[(tb + t) * 1024 + ce] = f2bf(o);
    }
}
__device__ void lru_naive(const Params& p, int l, int item) {
    const int lane = TID() & 63, b = item >> 2, c = (item & 3) * 64 + lane;
    const bf16_t* proj = (const bf16_t*)(p.ws + WS_R); const bf16_t* Z = (const bf16_t*)(p.ws + WS_Z); bf16_t* mix = (bf16_t*)(p.ws + WS_MIX);
    const float* lcw = p.in[I_LCW] + (size_t)l * 4 * 256 + c;
    const float w0 = lcw[0], w1 = lcw[256], w2 = lcw[512], w3 = lcw[768], cb = p.in[I_LCB][l * 256 + c];
    const float sp = softplus(-p.in[I_LLAM][l * 256 + c]);
    float x0 = 0.f, x1 = 0.f, x2 = 0.f, hst = 0.f;
    const size_t tb = (size_t)b * SEQ;
    float xn = bf2f(proj[tb * NP + C_CX + c]), yn = bf2f(proj[tb * NP + C_CY + c]), zrn = bf2f(Z[tb * 512 + c]), zin = bf2f(Z[tb * 512 + 256 + c]);
    for (int t = 0; t < SEQ; ++t) {
        const float x3 = xn, y = yn, zr = zrn, zi = zin;
        {
            const size_t tok = tb + (t + 1 < SEQ ? t + 1 : t);
            xn = bf2f(proj[tok * NP + C_CX + c]); yn = bf2f(proj[tok * NP + C_CY + c]); zrn = bf2f(Z[tok * 512 + c]); zin = bf2f(Z[tok * 512 + 256 + c]);
        }
        const float xc = w0 * x0 + w1 * x1 + w2 * x2 + w3 * x3 + cb;
        x0 = x1; x1 = x2; x2 = x3;
        const float r = sigm(zr), ig = sigm(zi);
        const float log_a = -8.f * r * sp, a = __expf(log_a);
        const float mult = (t == 0) ? 1.f : sqrtf(fmaxf(-expm1f(2.f * log_a), EPS));
        hst = a * hst + mult * ig * xc;
        mix[(tb + t) * 1024 + 768 + c] = f2bf(gelu_tanh(y) * hst);
    }
}
__device__ unsigned g_bar[1024];
__device__ __forceinline__ unsigned xcc_id() { return (unsigned)__builtin_amdgcn_s_getreg((3 << 11) | 20) & 0xFu; }
__device__ __forceinline__ void grid_barrier(unsigned epoch, unsigned n_x, unsigned n_xcd, unsigned base_x, unsigned base_g) {
    asm volatile("s_waitcnt vmcnt(0) lgkmcnt(0)" ::: "memory");
    __syncthreads();
    if (threadIdx.x == 0) {
        const unsigned x = xcc_id() & 7u;
        const unsigned old = __hip_atomic_fetch_add(&g_bar[x * 64], 1u, __ATOMIC_RELAXED, __HIP_MEMORY_SCOPE_AGENT);
        if (old + 1u - base_x == epoch * n_x) {
            __builtin_amdgcn_fence(__ATOMIC_RELEASE, "agent");
            __hip_atomic_fetch_add(&g_bar[512], 1u, __ATOMIC_RELAXED, __HIP_MEMORY_SCOPE_AGENT);
        }
        while (__hip_atomic_load(&g_bar[512], __ATOMIC_RELAXED, __HIP_MEMORY_SCOPE_AGENT) - base_g < epoch * n_xcd) __builtin_amdgcn_s_sleep(1);
        __builtin_amdgcn_fence(__ATOMIC_ACQUIRE, "agent");
    }
    __syncthreads();
}
__device__ __forceinline__ void sub_barrier(unsigned epoch, unsigned n, unsigned base) {
    asm volatile("s_waitcnt vmcnt(0) lgkmcnt(0)" ::: "memory");
    __syncthreads();
    if (threadIdx.x == 0) {
        __builtin_amdgcn_fence(__ATOMIC_RELEASE, "agent");
        __hip_atomic_fetch_add(&g_bar[640], 1u, __ATOMIC_RELAXED, __HIP_MEMORY_SCOPE_AGENT);
        while (__hip_atomic_load(&g_bar[640], __ATOMIC_RELAXED, __HIP_MEMORY_SCOPE_AGENT) - base < epoch * n) __builtin_amdgcn_s_sleep(1);
        __builtin_amdgcn_fence(__ATOMIC_ACQUIRE, "agent");
    }
    __syncthreads();
}
__device__ void phase_m1(const Params& p, int l, unsigned char* smem) {
    {
        u32x4 pq[3], pk[3], pv[3]; const bf16_t* proj = (const bf16_t*)(p.ws + WS_R);
        if (PROBE_DUP & 1) { gdn_raw_load(proj, BID(), 0, TID(), pq); gdn_raw_load(proj, BID(), 1, TID(), pk); gdn_raw_load(proj, BID(), 2, TID(), pv);
            for (int u = BID(); u < 2048; u += gridDim.x) gdn_unit_m1(p, l, u, u + (int)gridDim.x, pq, pk, pv, smem, false); }
        gdn_raw_load(proj, BID(), 0, TID(), pq); gdn_raw_load(proj, BID(), 1, TID(), pk); gdn_raw_load(proj, BID(), 2, TID(), pv);
        for (int u = BID(); u < 2048; u += gridDim.x) gdn_unit_m1(p, l, u, u + (int)gridDim.x, pq, pk, pv, smem);
    }
    lru_load_wt(p, l, smem);
    if (PROBE_DUP & 128) for (int u = BID(); u < 512; u += gridDim.x) lru_unit_a(p, l, u, smem);
    for (int u = BID(); u < 512; u += gridDim.x) lru_unit_a(p, l, u, smem);
    __syncthreads();
    float* lbs = (float*)(smem + 120 * 1024);
    if (TID() < 256) lbs[TID()] = lower_bound(p.in[I_LB], l, TID());
    __syncthreads();
    if (!HGRN_NAIVE) { u32x4 hp[3]; hgrn_load(p, BID(), TID(), hp);
        for (int u = BID(); u < 2048; u += gridDim.x) hgrn_unit<false>(p, l, u, u + (int)gridDim.x, hp, smem, lbs); }
}
#ifndef HG_SPLIT
#define HG_SPLIT 2048
#endif
__device__ void phase_m2(const Params& p, int l, unsigned char* smem, unsigned sub_base) {
    const int bid = BID(), tid = TID();
    if (bid < 128) { const int item = (((bid & 7) * 2 + (bid >> 6)) << 3) | ((bid >> 3) & 7);
        if (PROBE_DUP & 2) gdn_seq<0>(p, l, item, smem); if (PROBE_DUP & 16) gdn_seq<1>(p, l, item, smem); if (PROBE_DUP & 32) gdn_seq<2>(p, l, item, smem); gdn_seq<0>(p, l, item, smem); return; }
    const int hb = bid - 128, nhb = gridDim.x - 128;
    if (HGRN_NAIVE && hb < 64 && tid < 64) hgrn_naive(p, l, hb);
    if (LRU_NAIVE && hb >= 64 && hb < 80 && tid < 64) lru_naive(p, l, hb - 64);
    if (!HGRN_NAIVE && tid < 128) { for (int gt = hb * 128 + tid; gt < 16384; gt += nhb * 128) hgrn_scan(p, gt); }
    else if (!LRU_NAIVE && tid >= 128 && tid < 192) { for (int gt = hb * 64 + (tid - 128); gt < 1024; gt += nhb * 64) lru_carry(p, gt); }
    sub_barrier((unsigned)(l + 1), (unsigned)nhb, sub_base);
    {
        float* lbs = (float*)(smem + 120 * 1024);
        if (tid < 256) lbs[tid] = lower_bound(p.in[I_LB], l, tid);
        __syncthreads();
        { u32x4 hp[3]; hgrn_load(p, hb, tid, hp);
          for (int u = hb; u < HG_SPLIT; u += nhb) hgrn_unit<true>(p, l, u, (u + nhb < HG_SPLIT) ? u + nhb : 4096, hp, smem, lbs); }
        __syncthreads();
    }
}

__device__ void phase_m3(const Params& p, int l, unsigned char* smem) {
    const int tid = TID(), lane = tid & 63, wv = tid >> 6;
    const bf16_t* proj = (const bf16_t*)(p.ws + WS_R); bf16_t* mix = (bf16_t*)(p.ws + WS_MIX);
    {
        float* ssx = (float*)smem;
        const int r = tid >> 3, es = r >> 3, t = (r & 7) * 8 + (tid & 7);
        const int kstep = (int)(gridDim.x >> 3);
        u32x4 nv0, nv1, nz0, nz1;
        {
            const int k = BID() >> 3, pair = (BID() & 7) * 2 + (k >> 7), u = (((pair >> 2) * 128 + (k & 127)) << 2) | (pair & 3); const size_t tk0 = (size_t)(u >> 2) * 64;
            if (k < 256) { const u32x4* s_ = (const u32x4*)(mix + (tk0 + r) * 1024 + 256 + (u & 3) * 128 + (tid & 7) * 16); nv0 = s_[0]; nv1 = s_[1];
                const u32x4* z_ = (const u32x4*)(proj + (tk0 + t) * NP + C_BZ + (u & 3) * 128 + es * 16); nz0 = z_[0]; nz1 = z_[1]; }
        }
        for (int k = BID() >> 3; k < 256; k += kstep) {
            const int pair = (BID() & 7) * 2 + (k >> 7), n_ = k & 127, u = (((pair >> 2) * 128 + n_) << 2) | (pair & 3);
            const int h = u & 3; const size_t tok0 = (size_t)(u >> 2) * 64;
            const u32x4 v0 = nv0, v1 = nv1, z0 = nz0, z1 = nz1;
            if (k + kstep < 256) {
                const int k2 = k + kstep, pair2 = (BID() & 7) * 2 + (k2 >> 7), u2 = (((pair2 >> 2) * 128 + (k2 & 127)) << 2) | (pair2 & 3); const size_t tk2 = (size_t)(u2 >> 2) * 64;
                const u32x4* s_ = (const u32x4*)(mix + (tk2 + r) * 1024 + 256 + (u2 & 3) * 128 + (tid & 7) * 16); nv0 = s_[0]; nv1 = s_[1];
                const u32x4* z_ = (const u32x4*)(proj + (tk2 + t) * NP + C_BZ + (u2 & 3) * 128 + es * 16); nz0 = z_[0]; nz1 = z_[1];
            }
            float o[16] = {lo_bf(v0.x), hi_bf(v0.x), lo_bf(v0.y), hi_bf(v0.y), lo_bf(v0.z), hi_bf(v0.z), lo_bf(v0.w), hi_bf(v0.w), lo_bf(v1.x), hi_bf(v1.x), lo_bf(v1.y), hi_bf(v1.y), lo_bf(v1.z), hi_bf(v1.z), lo_bf(v1.w), hi_bf(v1.w)};
            float sq = 0.f;
#pragma unroll
            for (int j = 0; j < 16; ++j) sq += o[j] * o[j];
            __syncthreads();
            ssx[es * 64 + t] = sq;
            __syncthreads();
            float tot = 0.f;
#pragma unroll
            for (int k8 = 0; k8 < 8; ++k8) tot += ssx[k8 * 64 + t];
            const float rr = rsqrtf(tot * (1.f / 128.f) + EPS);
            const float zz[16] = {lo_bf(z0.x), hi_bf(z0.x), lo_bf(z0.y), hi_bf(z0.y), lo_bf(z0.z), hi_bf(z0.z), lo_bf(z0.w), hi_bf(z0.w), lo_bf(z1.x), hi_bf(z1.x), lo_bf(z1.y), hi_bf(z1.y), lo_bf(z1.z), hi_bf(z1.z), lo_bf(z1.w), hi_bf(z1.w)};
            const float* g = p.in[I_GNG] + l * 128 + es * 16;
            float y[16];
#pragma unroll
            for (int j = 0; j < 16; ++j) y[j] = o[j] * rr * g[j] * silu(zz[j]);
            u32x4 w0, w1;
            w0.x = cvt_pk_bf16(y[0], y[1]); w0.y = cvt_pk_bf16(y[2], y[3]); w0.z = cvt_pk_bf16(y[4], y[5]); w0.w = cvt_pk_bf16(y[6], y[7]);
            w1.x = cvt_pk_bf16(y[8], y[9]); w1.y = cvt_pk_bf16(y[10], y[11]); w1.z = cvt_pk_bf16(y[12], y[13]); w1.w = cvt_pk_bf16(y[14], y[15]);
            u32x4* dst = (u32x4*)(mix + (tok0 + t) * 1024 + 256 + h * 128 + es * 16);
            dst[0] = w0; dst[1] = w1;
        }
        __syncthreads();
    }
    for (int u0 = BID() * 2; u0 < 512; u0 += gridDim.x * 2) lru_unit_c(p, l, u0 + (tid >> 8), tid & 255);
    __syncthreads();
    {
    float* tile = (float*)smem;
    convert_w(p.in[I_WOUT] + (size_t)l * DM * DM, DM, 0, nullptr, (bf16_t*)(p.ws + WS_WOUT), DM, DM, tile, BID(), (int)gridDim.x);
    convert_w(p.in[I_WUP] + (size_t)l * DM * DFF, DFF, 0, p.in[I_N2G] + l * DM, (bf16_t*)(p.ws + WS_WUP), DFF, DM, tile, BID(), (int)gridDim.x);
    convert_w(p.in[I_WDN] + (size_t)l * DFF * DM, DM, 0, nullptr, (bf16_t*)(p.ws + WS_WDN), DM, DFF, tile, BID(), (int)gridDim.x);
    if (l + 1 < DEPTH) convert_w(p.in[I_WIN] + (size_t)(l + 1) * DM * DIN, DIN, 1, p.in[I_N1G] + (l + 1) * DM, (bf16_t*)(p.ws + WS_WIN), NP, DM, tile, BID(), (int)gridDim.x);
    }
    if (HG_SPLIT < 2048) {
        __syncthreads();
        float* lbs = (float*)(smem + 120 * 1024);
        if (tid < 256) lbs[tid] = lower_bound(p.in[I_LB], l, tid);
        __syncthreads();
        { u32x4 hp[3]; if (HG_SPLIT + BID() < 2048) hgrn_load(p, HG_SPLIT + BID(), tid, hp);
          for (int u = HG_SPLIT + BID(); u < 2048; u += gridDim.x) hgrn_unit<true>(p, l, u, u + (int)gridDim.x, hp, smem, lbs); }
    }
}

__device__ void phase_final(const Params& p) {
    const int tid = TID(), lane = tid & 63, gw = BID() * 8 + (tid >> 6), nw = gridDim.x * 8;
    const float* ss = (const float*)(p.ws + WS_SS); const float* g = p.in[I_FNG];
    f32x4 gv[4];
#pragma unroll
    for (int i = 0; i < 4; ++i) gv[i] = *(const f32x4*)(g + (i * 64 + lane) * 4);
    for (int row0 = gw; row0 < T; row0 += 4 * nw) {
        f32x4 v[4][4]; float rs[4];
#pragma unroll
        for (int r = 0; r < 4; ++r) { const int row = row0 + r * nw < T ? row0 + r * nw : row0;
            rs[r] = row_rstd(ss, row);
#pragma unroll
            for (int i = 0; i < 4; ++i) v[r][i] = *(const f32x4*)(p.out + (size_t)row * 1024 + (i * 64 + lane) * 4); }
#pragma unroll
        for (int r = 0; r < 4; ++r) { const int row = row0 + r * nw;
            if (row < T) {
#pragma unroll
                for (int i = 0; i < 4; ++i) *(f32x4*)(p.out + (size_t)row * 1024 + (i * 64 + lane) * 4) = v[r][i] * rs[r] * gv[i]; } }
    }
}

constexpr int N_PHASES = 2 + 7 * DEPTH;
__device__ __forceinline__ void run_phase(const Params& p, int ph, unsigned char* smem, unsigned sub_base) {
    if (ph == 0) { phase_init(p, smem); return; }
    if (ph == N_PHASES - 1) { phase_final(p); return; }
    const int l = (ph - 1) / 7, k = (ph - 1) % 7;
    PG8_LAS unsigned char* lds = (PG8_LAS unsigned char*)smem;
    float* ss = (float*)(p.ws + WS_SS);
    pg8::StaticOrder S;
    if (k == 0) {
        pg8::Gemm g{(const bf16_t*)(p.ws + WS_XB), (const bf16_t*)(p.ws + WS_WIN), T, NP, DM}; S.init(T, NP, gridDim.x, BID());
        EpiScaled<0> E{(bf16_t*)(p.ws + WS_R), NP, ss};
        if (PROBE_DUP & 8) pg8::gemm_phase<EpiScaled<0>, pg8::StaticOrder, true, true>(lds, g, S, E);
        pg8::gemm_phase<EpiScaled<0>, pg8::StaticOrder, true, true>(lds, g, S, E);
        if (PROBE_DUP & 128) phase_gates(p, l, smem);
        phase_gates(p, l, smem);
    } else if (k == 1) phase_m1(p, l, smem);
    else if (k == 2) phase_m2(p, l, smem, sub_base);
    else if (k == 3) phase_m3(p, l, smem);
    else if (k == 4 || k == 6) {
        pg8::Gemm g{(const bf16_t*)(p.ws + (k == 4 ? WS_MIX : WS_R)), (const bf16_t*)(p.ws + (k == 4 ? WS_WOUT : WS_WDN)), T, DM, k == 4 ? DM : DFF}; S.init(T, DM, gridDim.x, BID());
        EpiResid E{(l == 0 && k == 4) ? p.in[I_X] : (const float*)p.out, p.out, (bf16_t*)(p.ws + WS_XB), ss + (size_t)(k == 4 ? 1 : 0) * T * 16};
        pg8::gemm_phase<EpiResid, pg8::StaticOrder, true, true>(lds, g, S, E);
    } else {
        pg8::Gemm g{(const bf16_t*)(p.ws + WS_XB), (const bf16_t*)(p.ws + WS_WUP), T, DFF, DM}; S.init(T, DFF, gridDim.x, BID());
        EpiScaled<1> E{(bf16_t*)(p.ws + WS_R), DFF, ss + (size_t)T * 16};
        if (PROBE_DUP & 256) pg8::gemm_phase<EpiScaled<1>, pg8::StaticOrder, true, true>(lds, g, S, E);
        pg8::gemm_phase<EpiScaled<1>, pg8::StaticOrder, true, true>(lds, g, S, E);
    }
}

#ifndef MK_COOP
#define MK_COOP 1
#endif
__global__ __launch_bounds__(512, 2) void mk_fwd(Params p, int ph_lo, int ph_hi) {
    extern __shared__ __attribute__((aligned(16))) unsigned char shm[];
    unsigned bar_epoch = 0, bar_nx = 0, bar_nxcd = 0;
    const unsigned my_xcc = xcc_id() & 7u;
    const unsigned bar_bx = __hip_atomic_load(&g_bar[my_xcc * 64], __ATOMIC_RELAXED, __HIP_MEMORY_SCOPE_AGENT), bar_bg = __hip_atomic_load(&g_bar[512], __ATOMIC_RELAXED, __HIP_MEMORY_SCOPE_AGENT), bar_bs = __hip_atomic_load(&g_bar[640], __ATOMIC_RELAXED, __HIP_MEMORY_SCOPE_AGENT);
    if (MK_COOP && threadIdx.x == 0) ((unsigned*)(p.ws + WS_Z))[blockIdx.x] = my_xcc;
    for (int ph = ph_lo; ph < ph_hi; ++ph) {
        const __attribute__((address_space(4))) Params* pp = (const __attribute__((address_space(4))) Params*)__builtin_amdgcn_kernarg_segment_ptr();
        asm volatile("" : "+s"(pp));
        Params q;
#pragma unroll
        for (int i = 0; i < 21; ++i) q.in[i] = pp->in[i];
        q.out = pp->out; q.ws = pp->ws;
        run_phase(q, ph, shm, bar_bs);
#if MK_COOP
        if (ph + 1 < ph_hi) {
            if (ph == ph_lo) {
                asm volatile("s_waitcnt vmcnt(0) lgkmcnt(0)" ::: "memory"); __syncthreads(); cg::this_grid().sync();
                unsigned seen = 0u;
                for (unsigned i = 0; i < gridDim.x; ++i) { const unsigned v = __hip_atomic_load((unsigned*)(p.ws + WS_Z) + i, __ATOMIC_RELAXED, __HIP_MEMORY_SCOPE_AGENT) & 7u; bar_nx += (v == my_xcc) ? 1u : 0u; seen |= 1u << v; }
                bar_nxcd = (unsigned)__builtin_popcount(seen);
            } else grid_barrier(++bar_epoch, bar_nx, bar_nxcd, bar_bx, bar_bg);
        }
#endif
    }
}

extern "C" void kernel_launch(void* const* d_in, const int* in_sizes, int n_in, void* d_out, int out_size, void* d_ws, size_t ws_size, hipStream_t stream) {
    static int grid = 0;
    constexpr int LDS_BYTES = 131072;
    if (grid == 0) {
        if (n_in != 21 || out_size != T * DM || ws_size < WS_END) { fprintf(stderr, "kernel_launch: unexpected shapes (n_in %d out %d ws %zu)\n", n_in, out_size, ws_size); grid = -1; return; }
        int dev = 0, cus = 0, per_cu = 0;
        hipGetDevice(&dev); hipDeviceGetAttribute(&cus, hipDeviceAttributeMultiprocessorCount, dev);
        if (hipFuncSetAttribute((const void*)mk_fwd, hipFuncAttributeMaxDynamicSharedMemorySize, LDS_BYTES) != hipSuccess) { fprintf(stderr, "kernel_launch: hipFuncSetAttribute failed\n"); grid = -1; return; }
        if (hipOccupancyMaxActiveBlocksPerMultiprocessor(&per_cu, (const void*)mk_fwd, 512, LDS_BYTES) != hipSuccess || per_cu < 1) { fprintf(stderr, "kernel_launch: occupancy query gave %d\n", per_cu); per_cu = 1; }
        (void)hipGetLastError();
        grid = cus * 1;
    }
    if (grid < 0) return;
    Params p{};
    for (int i = 0; i < 21; ++i) p.in[i] = (const float*)d_in[i];
    p.out = (float*)d_out; p.ws = (unsigned char*)d_ws;
#if MK_COOP
    int lo = 0, hi = N_PHASES;
    void* args[] = {&p, &lo, &hi};
    hipError_t e = hipLaunchCooperativeKernel((const void*)mk_fwd, dim3(grid), dim3(512), args, LDS_BYTES, stream);
    if (e != hipSuccess) fprintf(stderr, "cooperative launch failed: %s (grid %d)\n", hipGetErrorString(e), grid);
#else
    for (int ph = 0; ph < N_PHASES; ++ph) hipLaunchKernelGGL(mk_fwd, dim3(grid), dim3(512), LDS_BYTES, stream, p, ph, ph + 1);
#endif
}
```

```cpp
#include <hip/hip_runtime.h>
#include <hip/hip_cooperative_groups.h>
#include <cstdio>
namespace cg = cooperative_groups;
namespace pg8 {
#define PG8_LAS __attribute__((address_space(3)))
typedef unsigned short bf16_t;
typedef short bf16x8 __attribute__((ext_vector_type(8)));
typedef float f32x4 __attribute__((ext_vector_type(4)));
typedef unsigned u32x4 __attribute__((ext_vector_type(4)));
constexpr int BM = 256, BK = 64, HALF = 128, HTB = HALF * BK * 2  , STAGE_BYTES = 8 * HTB, NXCD = 8, WGM = 8;

__host__ __device__ __forceinline__ int lds_byte(int r, int c) { const int st = (r >> 4) * 2 + (c >> 5), rr = r & 15, cc = c & 31, ob = rr * 64 + cc * 2; return st * 1024 + (ob ^ (((ob >> 9) & 1) << 5)); }
__host__ __device__ __forceinline__ void stage_rc(int b, int& R, int& C) { const int st = b / 1024, sb = b % 1024, swz = sb ^ (((sb >> 9) & 1) << 5); R = (st >> 1) * 16 + swz / 64; C = (st & 1) * 32 + (swz % 64) / 2; }
__host__ __device__ __forceinline__ int perm32(int rho) { const int n = rho >> 4, i = rho & 15; return 8 * (i >> 2) + 4 * n + (i & 3); }

struct Unit { int pm, pn; };
struct Gemm { const bf16_t* A; const bf16_t* Bt; int M, N, K; };

struct StaticOrder {
    int nM, nN, nwg, G, c;
    __host__ __device__ void init(int M, int N, int G_, int c_) { nM = M / BM; nN = N / BM; nwg = nM * nN; G = G_; c = c_; }
    __host__ __device__ bool next(int i, Unit& u) const {
        const long L = (long)i * G + c; if (L >= nwg) return false;
        int wgid = (int)L; { const int q = nwg / NXCD, r = nwg % NXCD, xcd = wgid % NXCD, off = wgid / NXCD; wgid = (xcd < r ? xcd * (q + 1) : r * (q + 1) + (xcd - r) * q) + off; }
        const int nig = WGM * nN, gid = wgid / nig, fm = gid * WGM, gsz = (nM - fm) < WGM ? (nM - fm) : WGM;
        u.pm = fm + ((wgid % nig) % gsz); u.pn = (wgid % nig) / gsz; return true;
    }
    __device__ __forceinline__ void a_ready(const Unit&) const {}
    __device__ __forceinline__ void done(const Unit&) const {}
};
__device__ __forceinline__ unsigned cvt_pk_bf16(float lo, float hi) { unsigned r; asm volatile("v_cvt_pk_bf16_f32 %0, %1, %2" : "=v"(r) : "v"(lo), "v"(hi)); return r; }
__device__ __forceinline__ int TID() { int t = threadIdx.x; asm volatile("" : "+v"(t)); return t; }
__device__ __forceinline__ int BID() { int t = blockIdx.x; asm volatile("" : "+s"(t)); return t; }
template <class Epi, class Sched, bool ALIGN_EPI = false, bool SP2 = false>
__device__ __forceinline__ void gemm_phase(PG8_LAS unsigned char* lds, const Gemm g, const Sched& S, const Epi& E) {
    const int tid = TID(), wid = __builtin_amdgcn_readfirstlane(tid >> 6), lane = tid & 63, wr = wid >> 2, wc = wid & 3, fr = lane & 15, fq = lane >> 4;
    const int K = g.K, nt = K / BK;
    unsigned voffA[2], voffB[2];
#pragma unroll
    for (int i = 0; i < 2; ++i) { int R, C; stage_rc(tid * 16 + i * 8192, R, C); const int Rb = Epi::PERM ? ((R & ~31) + perm32(R & 31)) : R;
        voffA[i] = (unsigned)(R * K + C) * 2u; voffB[i] = (unsigned)(Rb * K + C) * 2u; }
    const size_t kstep = (size_t)(BK * 2);
    const size_t hstep = (size_t)HALF * K * 2;
    const size_t tstep = 2 * hstep;
    const unsigned ldsw = (unsigned)wid * 1024u;
    const int aoff = lds_byte(wr * 64 + fr, fq * 8), boff = lds_byte(wc * 32 + fr, fq * 8);
#define PG8_SA(b, h) (((b) * 2 + (h)) * HTB)
#define PG8_SB(b, h) ((4 + (b) * 2 + (h)) * HTB)
#define PG8_STAGE(bufoff, gbase, voff) do { _Pragma("unroll") for (int _i = 0; _i < 2; ++_i) \
        __builtin_amdgcn_global_load_lds((const unsigned*)((const char*)(gbase) + (voff)[_i]), (PG8_LAS unsigned*)(lds + (bufoff) + ldsw + _i * 8192), 16, 0, 0); } while (0)
#define PG8_LDA(dst, b, h) do { _Pragma("unroll") for (int m = 0; m < 4; ++m) _Pragma("unroll") for (int k = 0; k < 2; ++k) dst[m][k] = *(const PG8_LAS bf16x8*)(lds + PG8_SA(b, h) + aoff + m * 2048 + k * 1024); } while (0)
#define PG8_LDB(dst, b, h) do { _Pragma("unroll") for (int n = 0; n < 2; ++n) _Pragma("unroll") for (int k = 0; k < 2; ++k) dst[n][k] = *(const PG8_LAS bf16x8*)(lds + PG8_SB(b, h) + boff + n * 2048 + k * 1024); } while (0)
#define PG8_MMA(ai, bj, At, Bt) do { __builtin_amdgcn_s_setprio(1); _Pragma("unroll") for (int m = 0; m < 4; ++m) _Pragma("unroll") for (int n = 0; n < 2; ++n) _Pragma("unroll") for (int k = 0; k < 2; ++k) \
        acc[ai][bj][m][n] = __builtin_amdgcn_mfma_f32_16x16x32_bf16(Bt[n][k], At[m][k], acc[ai][bj][m][n], 0, 0, 0); __builtin_amdgcn_s_setprio(0); } while (0)
#define PG8_WAIT_V(n) asm volatile("s_waitcnt vmcnt(" #n ")" ::: "memory")
#define PG8_WAIT_L(n) asm volatile("s_waitcnt lgkmcnt(" #n ")" ::: "memory")
#define PG8_BAR __builtin_amdgcn_s_barrier()
#define PG8_SCHED __builtin_amdgcn_sched_barrier(0)
    Unit cur, nxt; int ui = 0;
    if (!S.next(0, cur)) return;
    f32x4 acc[2][2][4][2];
#pragma unroll
    for (int a = 0; a < 2; ++a)
#pragma unroll
        for (int b = 0; b < 2; ++b)
#pragma unroll
            for (int m = 0; m < 4; ++m)
#pragma unroll
                for (int n = 0; n < 2; ++n) acc[a][b][m][n] = (f32x4){0.f, 0.f, 0.f, 0.f};
    bf16x8 At[4][2], B0[2][2], B1[2][2];
    const char* cA = (const char*)g.A + (size_t)cur.pm * tstep; const char* cB = (const char*)g.Bt + (size_t)cur.pn * tstep;
    S.a_ready(cur);
    if constexpr (SP2) {
        PG8_STAGE(PG8_SB(0, 0), cB, voffB); PG8_STAGE(PG8_SB(0, 1), cB + hstep, voffB); PG8_STAGE(PG8_SA(0, 0), cA, voffA); PG8_STAGE(PG8_SA(0, 1), cA + hstep, voffA);
        if (wr == 1) PG8_BAR;
        PG8_WAIT_V(2); PG8_BAR;
        PG8_STAGE(PG8_SB(1, 0), cB + kstep, voffB); PG8_STAGE(PG8_SA(1, 0), cA + kstep, voffA); PG8_STAGE(PG8_SB(1, 1), cB + hstep + kstep, voffB);
        PG8_WAIT_V(6); PG8_BAR;
    } else {
        PG8_STAGE(PG8_SB(0, 0), cB, voffB); PG8_STAGE(PG8_SA(0, 0), cA, voffA); PG8_STAGE(PG8_SB(0, 1), cB + hstep, voffB); PG8_STAGE(PG8_SA(0, 1), cA + hstep, voffA);
        if (wr == 1) PG8_BAR;
        PG8_WAIT_V(4); PG8_BAR;
        PG8_STAGE(PG8_SB(1, 0), cB + kstep, voffB); PG8_STAGE(PG8_SA(1, 0), cA + kstep, voffA); PG8_STAGE(PG8_SB(1, 1), cB + hstep + kstep, voffB);
        PG8_WAIT_V(6); PG8_BAR;
    }
    for (;;) {
        const bool has_next = S.next(ui + 1, nxt);
        const char* nA = has_next ? (const char*)g.A + (size_t)nxt.pm * tstep : cA; const char* nB = has_next ? (const char*)g.Bt + (size_t)nxt.pn * tstep : cB;
        for (int t = 0; t < nt; t += 2) {
            const bool last = (t == nt - 2);
            const char* a1 = cA + (size_t)(t + 1) * kstep;
            const char* a2 = last ? nA : cA + (size_t)(t + 2) * kstep; const char* b2 = last ? nB : cB + (size_t)(t + 2) * kstep;
            const char* a3 = a2 + kstep; const char* b3 = b2 + kstep;
            if (last && has_next) S.a_ready(nxt);
            if constexpr (SP2) {
            PG8_LDB(B0, 0, 0); PG8_LDB(B1, 0, 1); PG8_SCHED; PG8_LDA(At, 0, 0); PG8_STAGE(PG8_SA(1, 1), a1 + hstep, voffA);
            PG8_WAIT_V(8); PG8_WAIT_L(0); PG8_BAR; PG8_MMA(0, 0, At, B0); PG8_MMA(0, 1, At, B1); PG8_BAR; PG8_SCHED;
            PG8_LDA(At, 0, 1); PG8_STAGE(PG8_SB(0, 0), b2, voffB); PG8_STAGE(PG8_SB(0, 1), b2 + hstep, voffB); PG8_STAGE(PG8_SA(0, 0), a2, voffA);
            PG8_WAIT_V(8); PG8_WAIT_L(0); PG8_BAR; PG8_MMA(1, 0, At, B0); PG8_MMA(1, 1, At, B1); PG8_BAR; PG8_SCHED;
            PG8_LDB(B0, 1, 0); PG8_LDB(B1, 1, 1); PG8_SCHED; PG8_LDA(At, 1, 0); PG8_STAGE(PG8_SA(0, 1), a2 + hstep, voffA);
            PG8_WAIT_V(8); PG8_WAIT_L(0); PG8_BAR; PG8_MMA(0, 0, At, B0); PG8_MMA(0, 1, At, B1); PG8_BAR; PG8_SCHED;
            PG8_LDA(At, 1, 1); PG8_STAGE(PG8_SB(1, 0), b3, voffB); PG8_STAGE(PG8_SB(1, 1), b3 + hstep, voffB); PG8_STAGE(PG8_SA(1, 0), a3, voffA);
            PG8_WAIT_V(8); PG8_WAIT_L(0); PG8_BAR; PG8_MMA(1, 0, At, B0); PG8_MMA(1, 1, At, B1); PG8_BAR; PG8_SCHED;
            } else {
            PG8_LDB(B0, 0, 0); PG8_SCHED; PG8_LDA(At, 0, 0); PG8_STAGE(PG8_SA(1, 1), a1 + hstep, voffA);
            PG8_WAIT_L(8); PG8_BAR; PG8_WAIT_L(0); PG8_MMA(0, 0, At, B0); PG8_BAR; PG8_SCHED;
            PG8_LDB(B1, 0, 1); PG8_STAGE(PG8_SB(0, 0), b2, voffB);
            PG8_BAR; PG8_WAIT_L(0); PG8_MMA(0, 1, At, B1); PG8_BAR;
            PG8_LDA(At, 0, 1); PG8_STAGE(PG8_SA(0, 0), a2, voffA);
            PG8_BAR; PG8_WAIT_L(0); PG8_MMA(1, 0, At, B0); PG8_BAR; PG8_SCHED;
            PG8_STAGE(PG8_SB(0, 1), b2 + hstep, voffB);
            PG8_WAIT_V(6); PG8_BAR; PG8_MMA(1, 1, At, B1); PG8_BAR;
            PG8_LDB(B0, 1, 0); PG8_SCHED; PG8_LDA(At, 1, 0); PG8_STAGE(PG8_SA(0, 1), a2 + hstep, voffA);
            PG8_WAIT_L(8); PG8_BAR; PG8_WAIT_L(0); PG8_MMA(0, 0, At, B0); PG8_BAR; PG8_SCHED;
            PG8_LDB(B1, 1, 1); PG8_STAGE(PG8_SB(1, 0), b3, voffB);
            PG8_BAR; PG8_WAIT_L(0); PG8_MMA(0, 1, At, B1); PG8_BAR;
            PG8_LDA(At, 1, 1); PG8_STAGE(PG8_SA(1, 0), a3, voffA);
            PG8_BAR; PG8_WAIT_L(0); PG8_MMA(1, 0, At, B0); PG8_BAR; PG8_SCHED;
            PG8_STAGE(PG8_SB(1, 1), b3 + hstep, voffB);
            PG8_WAIT_V(6); PG8_BAR; PG8_MMA(1, 1, At, B1); PG8_BAR;
            }
        }
        if constexpr (ALIGN_EPI) { if (wr == 0) PG8_BAR; }
        if constexpr (!Epi::AFTER_DRAIN) { E(acc, cur, wr, wc, fr, fq); S.done(cur); }
        if (!has_next) break;
#pragma unroll
        for (int a = 0; a < 2; ++a)
#pragma unroll
            for (int b = 0; b < 2; ++b)
#pragma unroll
                for (int m = 0; m < 4; ++m)
#pragma unroll
                    for (int n = 0; n < 2; ++n) acc[a][b][m][n] = (f32x4){0.f, 0.f, 0.f, 0.f};
        cur = nxt; cA = nA; cB = nB; ++ui;
        if constexpr (ALIGN_EPI) { if (wr == 1) PG8_BAR; }
    }
    PG8_WAIT_V(0);
    if constexpr (!ALIGN_EPI) { if (wr == 0) PG8_BAR; }
    PG8_BAR;
    if constexpr (Epi::AFTER_DRAIN) { E.fused(acc, cur, wr, wc, fr, fq, lds, wid, lane); S.done(cur); }
#undef PG8_SA
#undef PG8_SB
#undef PG8_STAGE
#undef PG8_LDA
#undef PG8_LDB
#undef PG8_MMA
#undef PG8_WAIT_V
#undef PG8_WAIT_L
#undef PG8_BAR
#undef PG8_SCHED
}
}

using pg8::TID; using pg8::BID; using pg8::bf16_t; using pg8::f32x4; using pg8::u32x4; using pg8::cvt_pk_bf16;
constexpr int T = 32768, SEQ = 8192, DM = 1024, DIN = 3592, NP = 3584, DFF = 4096, DEPTH = 4;
constexpr float EPS = 1e-6f;
constexpr size_t MiB = (size_t)1 << 20;
constexpr size_t WS_XB = 0, WS_WIN = 64 * MiB, WS_WOUT = 71 * MiB, WS_WUP = 73 * MiB, WS_WDN = 81 * MiB, WS_R = 89 * MiB, WS_Z = WS_R + 224 * MiB, WS_HS = 480 * MiB, WS_HS2 = WS_HS, WS_QK = 496 * MiB,
                 WS_MIX = 345 * MiB, WS_S1 = 409 * MiB, WS_GATES = 473 * MiB, WS_SS = 474 * MiB, WS_HCD = 478 * MiB, WS_LAGG = WS_HCD + MiB / 2, WS_LCAR = WS_LAGG + MiB, WS_END = 512 * MiB;
constexpr int C_AQ = 0, C_AF = 256, C_AI = 512, C_AG = 768, C_BQ = 1024, C_BK = 1536, C_BV = 2048, C_BZ = 2560, C_CX = 3072, C_CY = 3328;
enum { I_X = 0, I_N1G, I_WIN, I_LB, I_HNG, I_GCW, I_GALOG, I_GDT, I_GNG, I_LCW, I_LCB, I_LWA, I_LBA, I_LWX, I_LBX, I_LLAM, I_WOUT, I_N2G, I_WUP, I_WDN, I_FNG };
struct Params { const float* in[21]; float* out; unsigned char* ws; };

__device__ __forceinline__ float bf2f(bf16_t v) { return __uint_as_float(((unsigned)v) << 16); }
__device__ __forceinline__ bf16_t f2bf(float f) { unsigned u = __float_as_uint(f); u += 0x7FFFu + ((u >> 16) & 1u); return (bf16_t)(u >> 16); }
__device__ __forceinline__ float lo_bf(unsigned w) { return __uint_as_float(w << 16); }
__device__ __forceinline__ float hi_bf(unsigned w) { return __uint_as_float(w & 0xffff0000u); }
__device__ __forceinline__ float sigm(float x) { return 1.f / (1.f + __expf(-x)); }
__device__ __forceinline__ float silu(float x) { return x * sigm(x); }
__device__ __forceinline__ float softplus(float x) { return fmaxf(x, 0.f) + log1pf(__expf(-fabsf(x))); }
__device__ __forceinline__ float gelu_tanh(float y) { const float u = 0.7978845608028654f * (y + 0.044715f * y * y * y); return 0.5f * y * (1.f + tanhf(u)); }
__device__ __forceinline__ float wave_sum(float v) {
#pragma unroll
    for (int o = 32; o; o >>= 1) v += __shfl_xor(v, o);
    return v;
}
__device__ __forceinline__ float row_rstd(const float* ssp, int row) {
    const f32x4 a = *(const f32x4*)(ssp + (size_t)row * 16), b = *(const f32x4*)(ssp + (size_t)row * 16 + 4), c = *(const f32x4*)(ssp + (size_t)row * 16 + 8), d = *(const f32x4*)(ssp + (size_t)row * 16 + 12);
    const f32x4 s = (a + b) + (c + d);
    return rsqrtf(((s[0] + s[1]) + (s[2] + s[3])) * (1.f / 1024.f) + EPS);
}
__device__ __forceinline__ float lower_bound(const float* lbl, int l, int c) {
    const float a0 = lbl[c], a1 = lbl[256 + c], a2 = lbl[512 + c], a3 = lbl[768 + c];
    const float m = fmaxf(fmaxf(a0, a1), fmaxf(a2, a3));
    const float e0 = expf(a0 - m), e1 = expf(a1 - m), e2 = expf(a2 - m), e3 = expf(a3 - m);
    const float inv = 1.f / (e0 + e1 + e2 + e3);
    float s = 0.f; if (l >= 1) s += e1; if (l >= 2) s += e2; if (l >= 3) s += e3;
    return fminf(fmaxf(s * inv, 0.f), 1.f - EPS);
}

template <int ACT  > struct EpiScaled {
    static constexpr bool PERM = true, AFTER_DRAIN = false;
    bf16_t* O; int ldc; const float* ss;
    __device__ __forceinline__ void operator()(const f32x4 (&acc)[2][2][4][2], const pg8::Unit& u, int wr, int wc, int fr, int fq) const {
        const int row0 = u.pm * 256 + wr * 64 + fr, col0 = u.pn * 256 + wc * 32 + 8 * fq;
#pragma unroll
        for (int ai = 0; ai < 2; ++ai)
#pragma unroll
            for (int m = 0; m < 4; ++m) {
                const int row = row0 + ai * 128 + m * 16;
                float sq; { const f32x4 a = *(const f32x4*)(ss + (size_t)row * 16 + fq * 4); sq = (a[0] + a[1]) + (a[2] + a[3]); }
                sq += __shfl_xor(sq, 16); sq += __shfl_xor(sq, 32);
                const float rs = rsqrtf(sq * (1.f / 1024.f) + EPS);
                bf16_t* rowp = O + (size_t)row * ldc + col0;
#pragma unroll
                for (int bj = 0; bj < 2; ++bj) {
                    f32x4 v0 = acc[ai][bj][m][0] * rs, v1 = acc[ai][bj][m][1] * rs;
                    if (ACT == 1) {
#pragma unroll
                        for (int j = 0; j < 4; ++j) { const float a = fmaxf(v0[j], 0.f), b = fmaxf(v1[j], 0.f); v0[j] = a * a; v1[j] = b * b; }
                    }
                    u32x4 w; w.x = cvt_pk_bf16(v0[0], v0[1]); w.y = cvt_pk_bf16(v0[2], v0[3]); w.z = cvt_pk_bf16(v1[0], v1[1]); w.w = cvt_pk_bf16(v1[2], v1[3]);
                    *(u32x4*)(rowp + bj * 128) = w;
                }
            }
    }
};
struct EpiResid {
    static constexpr bool PERM = true, AFTER_DRAIN = false;
    const float* Xsrc; float* X; bf16_t* XB; float* ssout;
    __device__ __forceinline__ void operator()(const f32x4 (&acc)[2][2][4][2], const pg8::Unit& u, int wr, int wc, int fr, int fq) const {
        const int row0 = u.pm * 256 + wr * 64 + fr, col0 = u.pn * 256 + wc * 32 + 8 * fq;
#pragma unroll
        for (int ai = 0; ai < 2; ++ai)
#pragma unroll
            for (int m = 0; m < 4; ++m) {
                const int row = row0 + ai * 128 + m * 16;
                const float* sp = Xsrc + (size_t)row * 1024 + col0; float* xp = X + (size_t)row * 1024 + col0; bf16_t* bp = XB + (size_t)row * 1024 + col0;
                float sq = 0.f;
#pragma unroll
                for (int bj = 0; bj < 2; ++bj) {
                    f32x4 v0 = *(const f32x4*)(sp + bj * 128) + acc[ai][bj][m][0], v1 = *(const f32x4*)(sp + bj * 128 + 4) + acc[ai][bj][m][1];
                    *(f32x4*)(xp + bj * 128) = v0; *(f32x4*)(xp + bj * 128 + 4) = v1;
                    u32x4 w; w.x = cvt_pk_bf16(v0[0], v0[1]); w.y = cvt_pk_bf16(v0[2], v0[3]); w.z = cvt_pk_bf16(v1[0], v1[1]); w.w = cvt_pk_bf16(v1[2], v1[3]);
                    *(u32x4*)(bp + bj * 128) = w;
#pragma unroll
                    for (int j = 0; j < 4; ++j) sq += v0[j] * v0[j] + v1[j] * v1[j];
                }
                sq += __shfl_xor(sq, 16); sq += __shfl_xor(sq, 32);
                if (fq == 0) ssout[(size_t)row * 16 + u.pn * 4 + wc] = sq;
            }
    }
};

__device__ void convert_w(const float* W, int ldw, int gate_skip  , const float* g, bf16_t* Bt, int N, int K, float* tile  , int first, int stride) {
    const int tid = TID(), ntn = N / 64, ntk = K / 64, ntiles = ntn * ntk;
    const int r0 = tid >> 4, c4 = (tid & 15) * 4;
    f32x4 nv[2];
    if (first < ntiles) { const int tn = first % ntn, tk = first / ntn, scol = tn * 64 + ((gate_skip && tn * 64 >= 3072) ? 8 : 0);
        nv[0] = *(const f32x4*)(W + (size_t)(tk * 64 + r0) * ldw + scol + c4); nv[1] = *(const f32x4*)(W + (size_t)(tk * 64 + r0 + 32) * ldw + scol + c4); }
    for (int ti = first; ti < ntiles; ti += stride) {
        const int tn = ti % ntn, tk = ti / ntn;
        const f32x4 v0 = nv[0], v1 = nv[1];
        if (ti + stride < ntiles) { const int t2 = ti + stride, tn2 = t2 % ntn, tk2 = t2 / ntn, scol2 = tn2 * 64 + ((gate_skip && tn2 * 64 >= 3072) ? 8 : 0);
            nv[0] = *(const f32x4*)(W + (size_t)(tk2 * 64 + r0) * ldw + scol2 + c4); nv[1] = *(const f32x4*)(W + (size_t)(tk2 * 64 + r0 + 32) * ldw + scol2 + c4); }
        __syncthreads();
        { float* tp = tile + r0 * 65 + c4; tp[0] = v0[0]; tp[1] = v0[1]; tp[2] = v0[2]; tp[3] = v0[3]; }
        { float* tp = tile + (r0 + 32) * 65 + c4; tp[0] = v1[0]; tp[1] = v1[1]; tp[2] = v1[2]; tp[3] = v1[3]; }
        __syncthreads();
        const int n = tid >> 3, k8 = (tid & 7) * 8;
        float v[8];
#pragma unroll
        for (int j = 0; j < 8; ++j) { v[j] = tile[(k8 + j) * 65 + n]; if (g) v[j] *= g[tk * 64 + k8 + j]; }
        u32x4 w; w.x = cvt_pk_bf16(v[0], v[1]); w.y = cvt_pk_bf16(v[2], v[3]); w.z = cvt_pk_bf16(v[4], v[5]); w.w = cvt_pk_bf16(v[6], v[7]);
        *(u32x4*)(Bt + (size_t)(tn * 64 + n) * K + tk * 64 + k8) = w;
    }
    __syncthreads();
}

__device__ void phase_init(const Params& p, unsigned char* smem) {
    const int tid = TID(), lane = tid & 63, gw = BID() * 8 + (tid >> 6), nw = gridDim.x * 8;
    float* ss = (float*)(p.ws + WS_SS);
    bf16_t* xb = (bf16_t*)(p.ws + WS_XB);
    for (int row0 = gw; row0 < T; row0 += 4 * nw) {
        f32x4 v[4][4];
#pragma unroll
        for (int r = 0; r < 4; ++r) { const int row = row0 + r * nw;
#pragma unroll
            for (int i = 0; i < 4; ++i) v[r][i] = row < T ? *(const f32x4*)(p.in[I_X] + (size_t)row * 1024 + (i * 64 + lane) * 4) : (f32x4){0.f, 0.f, 0.f, 0.f}; }
#pragma unroll
        for (int r = 0; r < 4; ++r) { const int row = row0 + r * nw;
            if (row < T) {
                bf16_t* brow = xb + (size_t)row * 1024; float sq = 0.f;
#pragma unroll
                for (int i = 0; i < 4; ++i) {
                    uint2 w; w.x = cvt_pk_bf16(v[r][i][0], v[r][i][1]); w.y = cvt_pk_bf16(v[r][i][2], v[r][i][3]);
                    *(uint2*)(brow + (i * 64 + lane) * 4) = w;
                    sq += v[r][i][0] * v[r][i][0] + v[r][i][1] * v[r][i][1] + v[r][i][2] * v[r][i][2] + v[r][i][3] * v[r][i][3];
                }
                sq = wave_sum(sq);
                if (lane < 16) ss[(size_t)row * 16 + lane] = lane == 0 ? sq : 0.f;
            } }
    }
    convert_w(p.in[I_WIN], DIN, 1, p.in[I_N1G], (bf16_t*)(p.ws + WS_WIN), NP, DM, (float*)smem, BID(), gridDim.x);
}

__device__ void phase_gates(const Params& p, int l, unsigned char* smem) {
    const int tid = TID(), lane = tid & 63, wv = tid >> 6;
    float* wg = (float*)smem;
    const float* W = p.in[I_WIN] + (size_t)l * DM * DIN; const float* g = p.in[I_N1G] + l * DM;
    __syncthreads();
    for (int i = tid; i < 8192; i += 512) { const int j = i & 7, k = i >> 3; wg[j * 1024 + k] = W[(size_t)k * DIN + 3072 + j] * g[k]; }
    __syncthreads();
    const bf16_t* xb = (const bf16_t*)(p.ws + WS_XB); const float* ss = (const float*)(p.ws + WS_SS); float* gates = (float*)(p.ws + WS_GATES);
    for (int t = BID() * 8 + wv; t < T; t += gridDim.x * 8) {
        float acc[8];
#pragma unroll
        for (int j = 0; j < 8; ++j) acc[j] = 0.f;
#pragma unroll
        for (int c = 0; c < 2; ++c) {
            const u32x4 xv = *(const u32x4*)(xb + (size_t)t * 1024 + c * 512 + lane * 8);
            float xf[8] = {lo_bf(xv.x), hi_bf(xv.x), lo_bf(xv.y), hi_bf(xv.y), lo_bf(xv.z), hi_bf(xv.z), lo_bf(xv.w), hi_bf(xv.w)};
#pragma unroll
            for (int j = 0; j < 8; ++j) {
                const f32x4 w0 = *(const f32x4*)(wg + j * 1024 + c * 512 + lane * 8), w1 = *(const f32x4*)(wg + j * 1024 + c * 512 + lane * 8 + 4);
                acc[j] += xf[0] * w0[0] + xf[1] * w0[1] + xf[2] * w0[2] + xf[3] * w0[3] + xf[4] * w1[0] + xf[5] * w1[1] + xf[6] * w1[2] + xf[7] * w1[3];
            }
        }
        float mine = 0.f;
#pragma unroll
        for (int j = 0; j < 8; ++j) { const float s = wave_sum(acc[j]); if (lane == j) mine = s; }
        if (lane < 8) {
            const float val = mine * row_rstd(ss, t);
            float o;
            if (lane < 4) o = sigm(val);
            else { const int h = lane - 4; o = -expf(p.in[I_GALOG][l * 4 + h]) * softplus(val + p.in[I_GDT][l * 4 + h]); }
            gates[(size_t)t * 8 + lane] = o;
        }
    }
    __syncthreads();
}

__device__ void gdn_qk_prep(const Params& p, int l) {
    const int tid = TID(), lane = tid & 63, wv = tid >> 6;
    const bf16_t* proj = (const bf16_t*)(p.ws + WS_R);
    bf16_t* s1 = (bf16_t*)(p.ws + WS_S1);
    {
        const int cc = wv * 128 + lane * 2;
        const float* cw = p.in[I_GCW] + (size_t)l * 4 * 1536;
        float w[4][2];
#pragma unroll
        for (int j = 0; j < 4; ++j) { w[j][0] = cw[j * 1536 + cc]; w[j][1] = cw[j * 1536 + cc + 1]; }
        const float post = wv < 4 ? 0.08838834764831845f : 1.f;
        for (int tile = BID(); tile < T / 128; tile += gridDim.x) {
            const int t0 = tile * 128;
            float x[3][2];
#pragma unroll
            for (int j = 0; j < 3; ++j) {
                if ((t0 % SEQ) == 0) { x[j][0] = 0.f; x[j][1] = 0.f; }
                else { const unsigned v = *(const unsigned*)(proj + (size_t)(t0 - 3 + j) * NP + C_BQ + cc); x[j][0] = lo_bf(v); x[j][1] = hi_bf(v); }
            }
            for (int t = t0; t < t0 + 128; ++t) {
                const unsigned v = *(const unsigned*)(proj + (size_t)t * NP + C_BQ + cc);
                const float a = lo_bf(v), b = hi_bf(v);
                const float y0 = silu(w[0][0] * x[0][0] + w[1][0] * x[1][0] + w[2][0] * x[2][0] + w[3][0] * a);
                const float y1 = silu(w[0][1] * x[0][1] + w[1][1] * x[1][1] + w[2][1] * x[2][1] + w[3][1] * b);
                const float r = rsqrtf(wave_sum(y0 * y0 + y1 * y1) + EPS) * post;
                *(unsigned*)(s1 + (size_t)t * 1024 + cc) = cvt_pk_bf16(y0 * r, y1 * r);
                x[0][0] = x[1][0]; x[0][1] = x[1][1]; x[1][0] = x[2][0]; x[1][1] = x[2][1]; x[2][0] = a; x[2][1] = b;
            }
        }
    }
}

__device__ void gdn_naive(const Params& p, int l, int item) {
    const int lane = TID() & 63, dg = lane >> 4, e = lane & 15;
    const int b = item >> 5, h = (item >> 3) & 3, eg = item & 7, ce = h * 128 + eg * 16 + e;
    const bf16_t* proj = (const bf16_t*)(p.ws + WS_R); const bf16_t* s1 = (const bf16_t*)(p.ws + WS_S1); const float* gates = (const float*)(p.ws + WS_GATES);
    bf16_t* mix = (bf16_t*)(p.ws + WS_MIX);
    const float* cw = p.in[I_GCW] + (size_t)l * 4 * 1536 + 1024 + ce;
    const float w0 = cw[0], w1 = cw[1536], w2 = cw[2 * 1536], w3 = cw[3 * 1536];
    float S[32];
#pragma unroll
    for (int i = 0; i < 32; ++i) S[i] = 0.f;
    float v0 = 0.f, v1 = 0.f, v2 = 0.f;
    const size_t tb = (size_t)b * SEQ;
    u32x4 kn[4], qn[4]; float vn, bn, an;
    {
        const bf16_t* kp = s1 + tb * 1024 + 512 + h * 128 + dg * 32; const bf16_t* qp = s1 + tb * 1024 + h * 128 + dg * 32;
#pragma unroll
        for (int i = 0; i < 4; ++i) { kn[i] = *(const u32x4*)(kp + i * 8); qn[i] = *(const u32x4*)(qp + i * 8); }
        vn = bf2f(proj[tb * NP + C_BV + ce]); bn = gates[tb * 8 + h]; an = gates[tb * 8 + 4 + h];
    }
    for (int t = 0; t < SEQ; ++t) {
        u32x4 kc[4], qc[4];
#pragma unroll
        for (int i = 0; i < 4; ++i) { kc[i] = kn[i]; qc[i] = qn[i]; }
        const float v3 = vn, beta = bn, alpha = __expf(an);
        {
            const size_t tok = tb + (t + 1 < SEQ ? t + 1 : t);
            const bf16_t* kp = s1 + tok * 1024 + 512 + h * 128 + dg * 32; const bf16_t* qp = s1 + tok * 1024 + h * 128 + dg * 32;
#pragma unroll
            for (int i = 0; i < 4; ++i) { kn[i] = *(const u32x4*)(kp + i * 8); qn[i] = *(const u32x4*)(qp + i * 8); }
            vn = bf2f(proj[tok * NP + C_BV + ce]); bn = gates[tok * 8 + h]; an = gates[tok * 8 + 4 + h];
        }
        const float vt = silu(w0 * v0 + w1 * v1 + w2 * v2 + w3 * v3);
        v0 = v1; v1 = v2; v2 = v3;
        float kf[32], qf[32];
#pragma unroll
        for (int i = 0; i < 4; ++i) {
            kf[i * 8 + 0] = lo_bf(kc[i].x); kf[i * 8 + 1] = hi_bf(kc[i].x); kf[i * 8 + 2] = lo_bf(kc[i].y); kf[i * 8 + 3] = hi_bf(kc[i].y);
            kf[i * 8 + 4] = lo_bf(kc[i].z); kf[i * 8 + 5] = hi_bf(kc[i].z); kf[i * 8 + 6] = lo_bf(kc[i].w); kf[i * 8 + 7] = hi_bf(kc[i].w);
            qf[i * 8 + 0] = lo_bf(qc[i].x); qf[i * 8 + 1] = hi_bf(qc[i].x); qf[i * 8 + 2] = lo_bf(qc[i].y); qf[i * 8 + 3] = hi_bf(qc[i].y);
            qf[i * 8 + 4] = lo_bf(qc[i].z); qf[i * 8 + 5] = hi_bf(qc[i].z); qf[i * 8 + 6] = lo_bf(qc[i].w); qf[i * 8 + 7] = hi_bf(qc[i].w);
        }
        float k0 = 0.f, k1 = 0.f, k2 = 0.f, k3 = 0.f;
#pragma unroll
        for (int i = 0; i < 32; i += 4) { k0 += kf[i] * S[i]; k1 += kf[i + 1] * S[i + 1]; k2 += kf[i + 2] * S[i + 2]; k3 += kf[i + 3] * S[i + 3]; }
        float ks = (k0 + k1) + (k2 + k3);
        ks += __shfl_xor(ks, 16); ks += __shfl_xor(ks, 32);
        const float c = beta * (vt - alpha * ks);
        float o0 = 0.f, o1 = 0.f, o2 = 0.f, o3 = 0.f;
#pragma unroll
        for (int i = 0; i < 32; i += 4) {
            S[i] = alpha * S[i] + kf[i] * c; o0 += qf[i] * S[i];
            S[i + 1] = alpha * S[i + 1] + kf[i + 1] * c; o1 += qf[i + 1] * S[i + 1];
            S[i + 2] = alpha * S[i + 2] + kf[i + 2] * c; o2 += qf[i + 2] * S[i + 2];
            S[i + 3] = alpha * S[i + 3] + kf[i + 3] * c; o3 += qf[i + 3] * S[i + 3];
        }
        float o = (o0 + o1) + (o2 + o3);
        o += __shfl_xor(o, 16); o += __shfl_xor(o, 32);
        if (dg == 0) mix[(tb + t) * 1024 + 256 + ce] = f2bf(o);
    }
}
__device__ __forceinline__ f32x4 mma16(const bf16_t* A, int lda, const bf16_t* B, int ldb, int ksteps, f32x4 acc, int fr, int fq) {
    for (int ks = 0; ks < ksteps; ++ks) {
        const pg8::bf16x8 a = *(const pg8::bf16x8*)(A + fr * lda + ks * 32 + fq * 8), b = *(const pg8::bf16x8*)(B + fr * ldb + ks * 32 + fq * 8);
        acc = __builtin_amdgcn_mfma_f32_16x16x32_bf16(a, b, acc, 0, 0, 0);
    }
    return acc;
}
__device__ __forceinline__ uint2 pack4(float a, float b, float c, float d) { uint2 w; w.x = (unsigned)f2bf(a) | ((unsigned)f2bf(b) << 16); w.y = (unsigned)f2bf(c) | ((unsigned)f2bf(d) << 16); return w; }

constexpr int L_WT = 0, L_XCB = 8 * 64 * 72 * 2, L_XLD = 264, L_ZS = L_XCB + 64 * L_XLD * 2;
__device__ void lru_load_wt(const Params& p, int l, unsigned char* smem) {
    const int tid = TID(); bf16_t* wt = (bf16_t*)(smem + L_WT);
    __syncthreads();
#pragma unroll
    for (int i = 0; i < 8; ++i) {
        const int item = tid + 512 * i, g = item >> 9, d = (item >> 3) & 63, e8 = (item & 7) * 8;
        const float* src = p.in[(g >> 2) ? I_LWX : I_LWA] + (size_t)l * 4 * 64 * 64 + (size_t)(g & 3) * 64 * 64 + d * 64 + e8;
        const f32x4 a = *(const f32x4*)src, bq = *(const f32x4*)(src + 4);
        bf16_t* dst = wt + g * 4608 + e8 * 72 + d;
        dst[0] = f2bf(a[0]); dst[72] = f2bf(a[1]); dst[144] = f2bf(a[2]); dst[216] = f2bf(a[3]); dst[288] = f2bf(bq[0]); dst[360] = f2bf(bq[1]); dst[432] = f2bf(bq[2]); dst[504] = f2bf(bq[3]);
    }
    __syncthreads();
}
__device__ void lru_unit_a(const Params& p, int l, int unit, unsigned char* smem) {
    const int tid = TID(), lane = tid & 63, wv = tid >> 6, fr = lane & 15, fq = lane >> 4;
    const bf16_t* wt = (const bf16_t*)(smem + L_WT); bf16_t* xcb = (bf16_t*)(smem + L_XCB); bf16_t* zs = (bf16_t*)(smem + L_ZS);
    const bf16_t* proj = (const bf16_t*)(p.ws + WS_R); bf16_t* Z = (bf16_t*)(p.ws + WS_Z);
    const size_t tok0 = (size_t)unit * 64; const int pos0 = (unit & 127) * 64;
    const float* lcw = p.in[I_LCW] + (size_t)l * 4 * 256; const float* lcb = p.in[I_LCB] + l * 256;
    __syncthreads();
    {
        const int c = tid & 255, th = tid >> 8;
        const float w0 = lcw[c], w1 = lcw[256 + c], w2 = lcw[512 + c], w3 = lcw[768 + c], cb = lcb[c];
        const int tk0 = th * 32;
        float x0 = 0.f, x1 = 0.f, x2 = 0.f;
        if (pos0 + tk0 > 0) { const bf16_t* q = proj + (tok0 + tk0 - 3) * NP + C_CX + c; x0 = bf2f(q[0]); x1 = bf2f(q[NP]); x2 = bf2f(q[2 * NP]); }
        bf16_t xin[32];
#pragma unroll
        for (int i = 0; i < 32; ++i) xin[i] = proj[(tok0 + tk0 + i) * NP + C_CX + c];
#pragma unroll
        for (int tk = tk0; tk < tk0 + 32; ++tk) {
            const float x3 = bf2f(xin[tk - tk0]);
            xcb[tk * L_XLD + c] = f2bf(w0 * x0 + w1 * x1 + w2 * x2 + w3 * x3 + cb);
            x0 = x1; x1 = x2; x2 = x3;
        }
    }
    __syncthreads();
    const int c = tid & 255;
    const float sp = softplus(-p.in[I_LLAM][l * 256 + c]);
    float P = 1.f, H = 0.f;
    for (int q = 0; q < 4; ++q) {
#pragma unroll
        for (int i = 0; i < 4; ++i) {
            const int id = wv * 4 + i, g = id >> 2, et = id & 3, gate = g >> 2, n = g & 3;
            const f32x4 acc = mma16(wt + g * 4608 + et * 16 * 72, 72, xcb + (q * 16) * L_XLD + n * 64, L_XLD, 2, (f32x4){0.f, 0.f, 0.f, 0.f}, fr, fq);
            const int e0 = et * 16 + fq * 4;
            const f32x4 bv = *(const f32x4*)(p.in[gate ? I_LBX : I_LBA] + l * 256 + n * 64 + e0);
            const uint2 zb = pack4(acc[0] + bv[0], acc[1] + bv[1], acc[2] + bv[2], acc[3] + bv[3]);
            *(uint2*)(zs + fr * 512 + gate * 256 + n * 64 + e0) = zb;
            *(uint2*)(Z + (tok0 + q * 16 + fr) * 512 + gate * 256 + n * 64 + e0) = zb;
        }
        __syncthreads();
        if (tid < 256) {
#pragma unroll
            for (int j = 0; j < 16; ++j) {
                const int tk = q * 16 + j;
                const float r = sigm(bf2f(zs[j * 512 + c])), ig = sigm(bf2f(zs[j * 512 + 256 + c]));
                const float log_a = -8.f * r * sp, a = __expf(log_a);
                const float mult = (pos0 + tk == 0) ? 1.f : sqrtf(fmaxf(-expm1f(2.f * log_a), EPS));
                H = a * H + mult * ig * bf2f(xcb[tk * L_XLD + c]); P *= a;
            }
        }
        __syncthreads();
    }
    if (tid < 256) ((float2*)(p.ws + WS_LAGG))[(size_t)unit * 256 + c] = make_float2(P, H);
}
__device__ void lru_carry(const Params& p, int gt  ) {
    const int b = gt >> 8, c = gt & 255;
    const float2* agg = (const float2*)(p.ws + WS_LAGG); float* car = (float*)(p.ws + WS_LCAR);
    float h = 0.f;
    for (int n0 = 0; n0 < 128; n0 += 8) {
        float2 a[8];
#pragma unroll
        for (int j = 0; j < 8; ++j) a[j] = agg[(size_t)(b * 128 + n0 + j) * 256 + c];
#pragma unroll
        for (int j = 0; j < 8; ++j) { car[(size_t)(b * 128 + n0 + j) * 256 + c] = h; h = a[j].x * h + a[j].y; }
    }
}
__device__ void lru_unit_c(const Params& p, int l, int unit, int c) {
    const bf16_t* proj = (const bf16_t*)(p.ws + WS_R); const bf16_t* Z = (const bf16_t*)(p.ws + WS_Z); bf16_t* mix = (bf16_t*)(p.ws + WS_MIX);
    const size_t tok0 = (size_t)unit * 64; const int pos0 = (unit & 127) * 64;
    const float* lcw = p.in[I_LCW] + (size_t)l * 4 * 256;
    const float w0 = lcw[c], w1 = lcw[256 + c], w2 = lcw[512 + c], w3 = lcw[768 + c], cb = p.in[I_LCB][l * 256 + c];
    const float sp = softplus(-p.in[I_LLAM][l * 256 + c]);
    float h = ((const float*)(p.ws + WS_LCAR))[(size_t)unit * 256 + c];
    float x0 = 0.f, x1 = 0.f, x2 = 0.f;
    if (pos0 > 0) { const bf16_t* q = proj + (tok0 - 3) * NP + C_CX + c; x0 = bf2f(q[0]); x1 = bf2f(q[NP]); x2 = bf2f(q[2 * NP]); }
    bf16_t nzr[8], nzi[8], nxs[8], nys[8];
#pragma unroll
    for (int j = 0; j < 8; ++j) { const size_t tok = tok0 + j; nzr[j] = Z[tok * 512 + c]; nzi[j] = Z[tok * 512 + 256 + c]; nxs[j] = proj[tok * NP + C_CX + c]; nys[j] = proj[tok * NP + C_CY + c]; }
    for (int g = 0; g < 8; ++g) {
        float zr[8], zi[8], xs[8], ys[8];
#pragma unroll
        for (int j = 0; j < 8; ++j) { zr[j] = bf2f(nzr[j]); zi[j] = bf2f(nzi[j]); xs[j] = bf2f(nxs[j]); ys[j] = bf2f(nys[j]); }
        if (g < 7) {
#pragma unroll
            for (int j = 0; j < 8; ++j) { const size_t tok = tok0 + (g + 1) * 8 + j; nzr[j] = Z[tok * 512 + c]; nzi[j] = Z[tok * 512 + 256 + c]; nxs[j] = proj[tok * NP + C_CX + c]; nys[j] = proj[tok * NP + C_CY + c]; }
        }
        float o[8];
#pragma unroll
        for (int j = 0; j < 8; ++j) {
            const int tk = g * 8 + j;
            const float xcv = bf2f(f2bf(w0 * x0 + w1 * x1 + w2 * x2 + w3 * xs[j] + cb));
            x0 = x1; x1 = x2; x2 = xs[j];
            const float r = sigm(zr[j]), ig = sigm(zi[j]);
            const float log_a = -8.f * r * sp, a = __expf(log_a);
            const float mult = (pos0 + tk == 0) ? 1.f : sqrtf(fmaxf(-expm1f(2.f * log_a), EPS));
            h = a * h + mult * ig * xcv;
            o[j] = gelu_tanh(ys[j]) * h;
        }
#pragma unroll
        for (int j = 0; j < 8; ++j) mix[(tok0 + g * 8 + j) * 1024 + 768 + c] = f2bf(o[j]);
    }
}

constexpr int HT_LD = 72, HT_BYTES = 64 * HT_LD * 2, H_CUM_BYTES = 64 * 65 * 4;
__device__ __forceinline__ void hgrn_load(const Params& p, int unit, int tid, u32x4 (&pf)[3]) {
    const bf16_t* pr = (const bf16_t*)(p.ws + WS_R) + ((size_t)(unit >> 2) * 64 + (tid >> 3)) * NP + (unit & 3) * 64 + (tid & 7) * 8;
    pf[0] = *(const u32x4*)(pr + C_AQ); pf[1] = *(const u32x4*)(pr + C_AF); pf[2] = *(const u32x4*)(pr + C_AI);
}
template <bool OUT> __device__ void hgrn_unit(const Params& p, int l, int unit, int next_unit, u32x4 (&pf)[3], unsigned char* smem, const float* lbs  ) {
    const int tid = TID(), lane = tid & 63, wv = tid >> 6, fr = lane & 15, fq = lane >> 4;
    const int h = unit & 3; const size_t tok0 = (size_t)(unit >> 2) * 64;
    const bf16_t* proj = (const bf16_t*)(p.ws + WS_R);
    float* cum = (float*)smem;
    bf16_t* tA = (bf16_t*)(smem + H_CUM_BYTES);
    bf16_t* tV = tA + 64 * HT_LD;
    bf16_t* tQ = tV + 64 * HT_LD;
    bf16_t* tD = tQ + 64 * HT_LD;
    bf16_t* tP = tD + 64 * HT_LD;
    bf16_t* tS = tP + 64 * HT_LD;
    float* sqx = (float*)(tS + 64 * HT_LD);

#ifdef HGRN_PROBE_U
    bf16_t* hs = (bf16_t*)(p.ws + WS_HS) + (size_t)unit * 4096;
#else
    bf16_t* hs = (bf16_t*)(p.ws + (OUT ? WS_HS2 : WS_HS)) + (size_t)unit * 4096;
#endif
    const int t = tid >> 3, d0 = (tid & 7) * 8;
    const u32x4 raq = pf[0], raf = pf[1], rai = pf[2];
    if (next_unit < 2048) hgrn_load(p, next_unit, tid, pf);
    const float aq[8] = {lo_bf(raq.x), hi_bf(raq.x), lo_bf(raq.y), hi_bf(raq.y), lo_bf(raq.z), hi_bf(raq.z), lo_bf(raq.w), hi_bf(raq.w)};
    const float af[8] = {lo_bf(raf.x), hi_bf(raf.x), lo_bf(raf.y), hi_bf(raf.y), lo_bf(raf.z), hi_bf(raf.z), lo_bf(raf.w), hi_bf(raf.w)};
    const float vv[8] = {lo_bf(rai.x), hi_bf(rai.x), lo_bf(rai.y), hi_bf(rai.y), lo_bf(rai.z), hi_bf(rai.z), lo_bf(rai.w), hi_bf(rai.w)};
    float q[8], kk[8];
    __syncthreads();
#pragma unroll
    for (int j = 0; j < 8; ++j) {
        const float lb = lbs[h * 64 + d0 + j];
        const float ex = __expf(-fminf(fmaxf(af[j], -80.f), 80.f)), sg = 1.f / (1.f + ex);
        const float f = fmaxf(lb + (1.f - lb) * sg, 1e-30f);
        kk[j] = (1.f - lb) * (ex * sg);
        q[j] = aq[j] / (1.f + __expf(-aq[j]));
        cum[t * 65 + d0 + j] = __logf(f);
    }
    __syncthreads();
    if (tid < 64) { float run = 0.f;
#pragma unroll 8
        for (int s = 0; s < 64; ++s) { run += cum[s * 65 + tid]; cum[s * 65 + tid] = run; } }
    __syncthreads();
    if (!OUT) {
#pragma unroll
        for (int j = 0; j < 8; ++j) {
            const float cl = cum[63 * 65 + d0 + j], c = cum[t * 65 + d0 + j];
            tA[(d0 + j) * HT_LD + t] = f2bf(kk[j] * __expf(cl - c));
            tV[(d0 + j) * HT_LD + t] = f2bf(vv[j]);
            if (t == 0) ((float*)(p.ws + WS_HCD))[(size_t)unit * 64 + d0 + j] = __expf(cl);
        }
        __syncthreads();
#pragma unroll
        for (int i = 0; i < 2; ++i) {
            const int tile = wv * 2 + i, dt = tile >> 2, et = tile & 3;
            const f32x4 acc = mma16(tA + dt * 16 * HT_LD, HT_LD, tV + et * 16 * HT_LD, HT_LD, 2, (f32x4){0.f, 0.f, 0.f, 0.f}, fr, fq);
            *(uint2*)(hs + (et * 16 + fr) * 64 + dt * 16 + fq * 4) = pack4(acc[0], acc[1], acc[2], acc[3]);
        }
    } else {
        float qt[8], kt[8], qd[8];
#pragma unroll
        for (int j = 0; j < 8; ++j) {
            const float cr = cum[31 * 65 + d0 + j], c = cum[t * 65 + d0 + j];
            qt[j] = q[j] * __expf(fminf(c - cr, 80.f)); kt[j] = kk[j] * __expf(fminf(cr - c, 80.f)); qd[j] = q[j] * __expf(c);
            tV[(d0 + j) * HT_LD + t] = f2bf(vv[j]);
        }
        { u32x4 w; w.x = cvt_pk_bf16(qt[0], qt[1]); w.y = cvt_pk_bf16(qt[2], qt[3]); w.z = cvt_pk_bf16(qt[4], qt[5]); w.w = cvt_pk_bf16(qt[6], qt[7]); *(u32x4*)(tQ + t * HT_LD + d0) = w; }
        { u32x4 w; w.x = cvt_pk_bf16(kt[0], kt[1]); w.y = cvt_pk_bf16(kt[2], kt[3]); w.z = cvt_pk_bf16(kt[4], kt[5]); w.w = cvt_pk_bf16(kt[6], kt[7]); *(u32x4*)(tA + t * HT_LD + d0) = w; }
        *(u32x4*)(tS + t * HT_LD + d0) = *(const u32x4*)(hs + t * 64 + d0);
        { u32x4 w; w.x = cvt_pk_bf16(qd[0], qd[1]); w.y = cvt_pk_bf16(qd[2], qd[3]); w.z = cvt_pk_bf16(qd[4], qd[5]); w.w = cvt_pk_bf16(qd[6], qd[7]); *(u32x4*)(tD + t * HT_LD + d0) = w; }
        __syncthreads();
#pragma unroll
        for (int i = 0; i < 2; ++i) {
            const int tile = wv * 2 + i, si = tile >> 2, tj = tile & 3;
            f32x4 acc = {0.f, 0.f, 0.f, 0.f};
            if (si <= tj) acc = mma16(tA + si * 16 * HT_LD, HT_LD, tQ + tj * 16 * HT_LD, HT_LD, 2, acc, fr, fq);
            const int tt = tj * 16 + fr, s0 = si * 16 + fq * 4;
            *(uint2*)(tP + tt * HT_LD + s0) = pack4(s0 <= tt ? acc[0] : 0.f, s0 + 1 <= tt ? acc[1] : 0.f, s0 + 2 <= tt ? acc[2] : 0.f, s0 + 3 <= tt ? acc[3] : 0.f);
        }
        __syncthreads();
        {
            const int tj = wv & 3, eh = wv >> 2, tt = tj * 16 + fr;
            f32x4 o[2]; float ssq = 0.f;
#pragma unroll
            for (int i = 0; i < 2; ++i) {
                const int et = eh * 2 + i;
                f32x4 acc = mma16(tV + et * 16 * HT_LD, HT_LD, tP + tj * 16 * HT_LD, HT_LD, 2, (f32x4){0.f, 0.f, 0.f, 0.f}, fr, fq);
                acc = mma16(tS + et * 16 * HT_LD, HT_LD, tD + tj * 16 * HT_LD, HT_LD, 2, acc, fr, fq);
                o[i] = acc; ssq += acc[0] * acc[0] + acc[1] * acc[1] + acc[2] * acc[2] + acc[3] * acc[3];
            }
            ssq += __shfl_xor(ssq, 16); ssq += __shfl_xor(ssq, 32);
            if (fq == 0) sqx[eh * 64 + tt] = ssq;
            __syncthreads();
            const float r = rsqrtf((sqx[tt] + sqx[64 + tt]) * (1.f / 64.f) + EPS);
            const float* g = p.in[I_HNG] + l * 64; bf16_t* mix = (bf16_t*)(p.ws + WS_MIX);
#pragma unroll
            for (int i = 0; i < 2; ++i) {
                const int e = (eh * 2 + i) * 16 + fq * 4;
                const uint2 gz = *(const uint2*)(proj + (tok0 + tt) * NP + C_AG + h * 64 + e);
                const f32x4 gv = *(const f32x4*)(g + e);
                *(uint2*)(mix + (tok0 + tt) * 1024 + h * 64 + e) = pack4(o[i][0] * r * gv[0] * silu(lo_bf(gz.x)), o[i][1] * r * gv[1] * silu(hi_bf(gz.x)),
                                                                          o[i][2] * r * gv[2] * silu(lo_bf(gz.y)), o[i][3] * r * gv[3] * silu(hi_bf(gz.y)));
            }
        }
    }
}
__device__ void hgrn_scan(const Params& p, int gt  ) {
    const int bh = gt >> 10, e = (gt >> 4) & 63, d4 = (gt & 15) * 4, b = bh >> 2, h = bh & 3;
    const bf16_t* hs = (const bf16_t*)(p.ws + WS_HS); bf16_t* hs2 = (bf16_t*)(p.ws + WS_HS2); const float* cdb = (const float*)(p.ws + WS_HCD);
    float S[4] = {0.f, 0.f, 0.f, 0.f};
    uint2 u[4], un[4]; f32x4 cd[4], cdn[4];
#pragma unroll
    for (int j = 0; j < 4; ++j) { const size_t unit = (size_t)(b * 128 + j) * 4 + h; u[j] = *(const uint2*)(hs + unit * 4096 + e * 64 + d4); cd[j] = *(const f32x4*)(cdb + unit * 64 + d4); }
    for (int n0 = 0; n0 < 128; n0 += 4) {
        if (n0 + 4 < 128) {
#pragma unroll
            for (int j = 0; j < 4; ++j) { const size_t unit = (size_t)(b * 128 + n0 + 4 + j) * 4 + h; un[j] = *(const uint2*)(hs + unit * 4096 + e * 64 + d4); cdn[j] = *(const f32x4*)(cdb + unit * 64 + d4); }
        }
#pragma unroll
        for (int j = 0; j < 4; ++j) {
            const size_t unit = (size_t)(b * 128 + n0 + j) * 4 + h;
            *(uint2*)(hs2 + unit * 4096 + e * 64 + d4) = pack4(S[0], S[1], S[2], S[3]);
            S[0] = cd[j][0] * S[0] + lo_bf(u[j].x); S[1] = cd[j][1] * S[1] + hi_bf(u[j].x); S[2] = cd[j][2] * S[2] + lo_bf(u[j].y); S[3] = cd[j][3] * S[3] + hi_bf(u[j].y);
        }
#pragma unroll
        for (int j = 0; j < 4; ++j) { u[j] = un[j]; cd[j] = cdn[j]; }
    }
}

constexpr int G_TMP = 0, G_VF = 32768, G_QB = 65536, G_LDB = 136, G_KB = G_QB + 64 * G_LDB * 2, G_AS = G_KB + 64 * G_LDB * 2, G_LDA = 68, G_SC = G_AS + 64 * G_LDA * 4;
__device__ __forceinline__ int frag_off(int r, int k, int KS) { return ((r >> 4) * KS + (k >> 5)) * 512 + ((((k >> 3) & 3) * 16 + (r & 15)) << 3) + (k & 7); }
__device__ __forceinline__ void gdn_raw_load(const bf16_t* proj, int unit, int sect, int tid, u32x4 (&v)[3]) {
    const int h = unit & 3, n = (unit >> 2) & 127; const size_t tok0 = (size_t)(unit >> 2) * 64; const int pcol0 = C_BQ + sect * 512 + h * 128;
#pragma unroll
    for (int i = 0; i < 3; ++i) {
        const int idx = tid + 512 * i, r = idx >> 4, c8 = (idx & 15) * 8;
        v[i] = (u32x4){0u, 0u, 0u, 0u};
        if (idx < 67 * 16 && (n > 0 || r >= 3)) v[i] = *(const u32x4*)(proj + (tok0 + r - 3) * NP + pcol0 + c8);
    }
}
__device__ __forceinline__ void gdn_raw_store(bf16_t* raw, int tid, const u32x4 (&v)[3]) {
#pragma unroll
    for (int i = 0; i < 3; ++i) { const int idx = tid + 512 * i; if (idx < 67 * 16) *(u32x4*)(raw + (idx >> 4) * 128 + (idx & 15) * 8) = v[i]; }
}
__device__ __forceinline__ void gdn_conv16(const Params& p, int l, const bf16_t* raw, int wch, int rg, int c, float* out) {
    const float* cw = p.in[I_GCW] + (size_t)l * 4 * 1536 + wch;
    const float w0 = cw[0], w1 = cw[1536], w2 = cw[3072], w3 = cw[4608];
    const int t0 = rg * 16; const bf16_t* q = raw + t0 * 128 + c;
    float x0 = bf2f(q[0]), x1 = bf2f(q[128]), x2 = bf2f(q[256]);
#pragma unroll
    for (int i = 0; i < 16; ++i) {
        const float x3 = bf2f(q[(i + 3) * 128]);
        out[(t0 + i) * 128 + c] = silu(w0 * x0 + w1 * x1 + w2 * x2 + w3 * x3);
        x0 = x1; x1 = x2; x2 = x3;
    }
}
#ifndef PROBE_DUP
#define PROBE_DUP 0
#endif
#ifndef PROBE_SKIP
#define PROBE_SKIP 0
#endif
__device__ void gdn_unit_m1(const Params& p, int l, int unit, int next_unit, u32x4 (&pq)[3], u32x4 (&pk)[3], u32x4 (&pv)[3], unsigned char* smem, bool fin = true) {
    const int skip = fin ? 0 : PROBE_SKIP;
    const int tid = TID(), lane = tid & 63, wv = tid >> 6, fr = lane & 15, fq = lane >> 4;
    const int h = unit & 3, n = (unit >> 2) & 127; const size_t tok0 = (size_t)(unit >> 2) * 64;
    float* tmp = (float*)(smem + G_TMP); float* vf = (float*)(smem + G_VF);
    bf16_t* qb = (bf16_t*)(smem + G_QB); bf16_t* kb = (bf16_t*)(smem + G_KB);
    float* As = (float*)(smem + G_AS); float* gcs = (float*)(smem + G_SC); float* bts = gcs + 64; float* egc = gcs + 128;
    const bf16_t* proj = (const bf16_t*)(p.ws + WS_R); float* gates = (float*)(p.ws + WS_GATES);
    bf16_t* uw = (bf16_t*)(p.ws + WS_XB) + (size_t)unit * 16384; bf16_t* qk1 = (bf16_t*)(p.ws + WS_S1) + (size_t)unit * 16384; bf16_t* qko = (bf16_t*)(p.ws + WS_QK) + (size_t)unit * 4096;
    const int c = tid & 127, rg = tid >> 7;
    __syncthreads();
    gdn_raw_store(qb, tid, pq); gdn_raw_store(kb, tid, pk); gdn_raw_store((bf16_t*)As, tid, pv);
    if (tid < 64) {
        float la = gates[(tok0 + tid) * 8 + 4 + h];
#pragma unroll
        for (int o = 1; o < 64; o <<= 1) { const float v = __shfl_up(la, o); if (lane >= o) la += v; }
        gcs[tid] = la; egc[tid] = __expf(la); bts[tid] = gates[(tok0 + tid) * 8 + h];
    }
    __syncthreads();
    gdn_conv16(p, l, qb, h * 128 + c, rg, c, tmp);
    gdn_conv16(p, l, kb, 512 + h * 128 + c, rg, c, vf);
    __syncthreads();
#pragma unroll
    for (int i = 0; i < 8; ++i) {
        const int t = wv * 8 + i; const float2 v = *(const float2*)(tmp + t * 128 + 2 * lane), v2 = *(const float2*)(vf + t * 128 + 2 * lane);
        const float r = rsqrtf(wave_sum(v.x * v.x + v.y * v.y) + EPS) * 0.08838834764831845f, r2 = rsqrtf(wave_sum(v2.x * v2.x + v2.y * v2.y) + EPS);
        *(unsigned*)(qb + t * G_LDB + 2 * lane) = (unsigned)f2bf(v.x * r) | ((unsigned)f2bf(v.y * r) << 16);
        *(unsigned*)(kb + t * G_LDB + 2 * lane) = (unsigned)f2bf(v2.x * r2) | ((unsigned)f2bf(v2.y * r2) << 16);
    }
    __syncthreads();
    gdn_conv16(p, l, (const bf16_t*)As, 1024 + h * 128 + c, rg, c, vf);
    __syncthreads();
#pragma unroll
    for (int i = 0; i < 4; ++i) {
        const int id = wv * 4 + i, kind = id >> 4, tile = id & 15, si = tile >> 2, tj = tile & 3;
        const int t = tj * 16 + fr, s0 = si * 16 + fq * 4;
        if (si <= tj) {
            const f32x4 acc = mma16(kb + si * 16 * G_LDB, G_LDB, (kind ? qb : kb) + tj * 16 * G_LDB, G_LDB, 4, (f32x4){0.f, 0.f, 0.f, 0.f}, fr, fq);
            const float gt = gcs[t]; const f32x4 gs = *(const f32x4*)(gcs + s0);
            float v[4];
#pragma unroll
            for (int j = 0; j < 4; ++j) v[j] = acc[j] * __expf(fminf(gt - gs[j], 0.f));
            if (kind == 0) { const float bt = bts[t];
                *(f32x4*)(As + t * G_LDA + s0) = (f32x4){s0 < t ? bt * v[0] : 0.f, s0 + 1 < t ? bt * v[1] : 0.f, s0 + 2 < t ? bt * v[2] : 0.f, s0 + 3 < t ? bt * v[3] : 0.f};
            } else *(uint2*)(qko + frag_off(t, s0, 2)) = pack4(s0 <= t ? v[0] : 0.f, s0 + 1 <= t ? v[1] : 0.f, s0 + 2 <= t ? v[2] : 0.f, s0 + 3 <= t ? v[3] : 0.f);
        } else if (kind == 1) *(uint2*)(qko + frag_off(t, s0, 2)) = make_uint2(0u, 0u);
    }
    __syncthreads();
    const float gcl = gcs[63];
    if (next_unit < 2048) { gdn_raw_load(proj, next_unit, 0, tid, pq); gdn_raw_load(proj, next_unit, 1, tid, pk); gdn_raw_load(proj, next_unit, 2, tid, pv); }
    if (tid >= 256) {
        const int tt = tid - 256;
        { const int t = tt >> 2, d0 = (tt & 3) * 32; const float eg = egc[t];
#pragma unroll
          for (int g = 0; g < 4; ++g) { const u32x4 qv = *(const u32x4*)(qb + t * G_LDB + d0 + g * 8); u32x4 w;
              const uint2 lo = pack4(lo_bf(qv.x) * eg, hi_bf(qv.x) * eg, lo_bf(qv.y) * eg, hi_bf(qv.y) * eg), hi = pack4(lo_bf(qv.z) * eg, hi_bf(qv.z) * eg, lo_bf(qv.w) * eg, hi_bf(qv.w) * eg);
              w.x = lo.x; w.y = lo.y; w.z = hi.x; w.w = hi.y; *(u32x4*)(qk1 + frag_off(t, d0 + g * 8, 4)) = w; } }
        { const int d = tt >> 1, sh = (tt & 1) * 32;
#pragma unroll
          for (int g = 0; g < 4; ++g) { float v[8];
#pragma unroll
              for (int j = 0; j < 8; ++j) { const int s = sh + g * 8 + j; v[j] = bf2f(kb[s * G_LDB + d]) * __expf(gcl - gcs[s]); }
              u32x4 w; const uint2 lo = pack4(v[0], v[1], v[2], v[3]), hi = pack4(v[4], v[5], v[6], v[7]);
              w.x = lo.x; w.y = lo.y; w.z = hi.x; w.w = hi.y; *(u32x4*)(qk1 + 8192 + frag_off(d, sh + g * 8, 2)) = w; } }
        if (tt == 0 && fin) gates[tok0 * 8 + 4 + h] = gcl;
    }
    if (!(skip & 1)) {
#pragma unroll 1
        for (int I = 0; I < 4; ++I) {
            float ad[4][16];
#pragma unroll
            for (int jj = 0; jj < 4; ++jj)
#pragma unroll
                for (int s4 = 0; s4 < 4; ++s4) { const f32x4 a = *(const f32x4*)(As + (I * 16 + fq * 4 + jj) * G_LDA + I * 16 + s4 * 4); ad[jj][s4 * 4] = a[0]; ad[jj][s4 * 4 + 1] = a[1]; ad[jj][s4 * 4 + 2] = a[2]; ad[jj][s4 * 4 + 3] = a[3]; }
            float x[2][4]; float* X[2];
#pragma unroll
            for (int c2 = 0; c2 < 2; ++c2) {
                const int col = (wv * 2 + c2) * 16 + fr;
                X[c2] = (col < 128 ? vf : tmp) + (col & 127);
                f32x4 acc = {0.f, 0.f, 0.f, 0.f};
                for (int J = 0; J < I; ++J)
#pragma unroll
                    for (int kk = 0; kk < 4; ++kk)
                        acc = __builtin_amdgcn_mfma_f32_16x16x4f32(As[(I * 16 + fr) * G_LDA + J * 16 + kk * 4 + fq], X[c2][(J * 16 + kk * 4 + fq) * 128], acc, 0, 0, 0);
#pragma unroll
                for (int jj = 0; jj < 4; ++jj) { const int t = I * 16 + fq * 4 + jj;
                    const float rhs = (col < 128) ? bts[t] * X[c2][t * 128] : bts[t] * egc[t] * bf2f(kb[t * G_LDB + (col & 127)]);
                    x[c2][jj] = rhs - acc[jj]; }
            }
#pragma unroll
            for (int r = 0; r < 16; ++r) {
                const float xr0 = __shfl(x[0][r & 3], (r >> 2) * 16 + fr), xr1 = __shfl(x[1][r & 3], (r >> 2) * 16 + fr);
#pragma unroll
                for (int jj = 0; jj < 4; ++jj) { x[0][jj] -= ad[jj][r] * xr0; x[1][jj] -= ad[jj][r] * xr1; }
            }
#pragma unroll
            for (int c2 = 0; c2 < 2; ++c2)
#pragma unroll
                for (int jj = 0; jj < 4; ++jj) X[c2][(I * 16 + fq * 4 + jj) * 128] = x[c2][jj];
        }
    }
    __syncthreads();
#pragma unroll
    for (int i = 0; i < 2; ++i) {
        const int pc = tid + 512 * i, blk = pc >> 6, ln = pc & 63, t = (blk >> 2) * 16 + (ln & 15), k0 = (blk & 3) * 32 + (ln >> 4) * 8;
        const f32x4 a = *(const f32x4*)(tmp + t * 128 + k0), bq = *(const f32x4*)(tmp + t * 128 + k0 + 4);
        u32x4 w; const uint2 lo = pack4(a[0], a[1], a[2], a[3]), hi = pack4(bq[0], bq[1], bq[2], bq[3]); w.x = lo.x; w.y = lo.y; w.z = hi.x; w.w = hi.y;
        *(u32x4*)(uw + 8192 + pc * 8) = w;
    }
#pragma unroll
    for (int i = 0; i < 4; ++i) {
        const int pc = tid + 512 * i, blk = pc >> 6, ln = pc & 63, e = (blk >> 2) * 16 + (ln & 15), t0 = (blk & 3) * 16 + (ln >> 4) * 4;
        *(uint2*)(uw + pc * 4) = pack4(vf[t0 * 128 + e], vf[(t0 + 1) * 128 + e], vf[(t0 + 2) * 128 + e], vf[(t0 + 3) * 128 + e]);
    }
}
template <int DRY> __device__ void gdn_seq(const Params& p, int l, int item, unsigned char* smem) {
    const int tid = TID(), lane = tid & 63, wv = tid >> 6, fr = lane & 15, fq = lane >> 4;
    const int b = item >> 5, h = (item >> 3) & 3, es = item & 7, tt = wv & 3; const bool isq = wv >= 4;
    bf16_t* Sl = (bf16_t*)smem;
    bf16_t* Vn = (bf16_t*)(smem + 4352);
    bf16_t* Ot = (bf16_t*)(smem + 6656);
    const bf16_t* UW = (const bf16_t*)(p.ws + WS_XB); const bf16_t* QKD = (const bf16_t*)(p.ws + WS_S1); const bf16_t* QKB = (const bf16_t*)(p.ws + WS_QK);
    const float* gates = (const float*)(p.ws + WS_GATES); bf16_t* mix = (bf16_t*)(p.ws + WS_MIX);
    const int zoff = tid >> 20;
    __syncthreads();
    for (int i = tid; i < 16 * 136 / 2; i += 512) ((unsigned*)Sl)[i] = 0u;
    __syncthreads();
    f32x4 S = {0.f, 0.f, 0.f, 0.f};
    pg8::bf16x8 A4[4][4], K2[4][2], Q2[4][2]; uint2 UU[4]; float GL[4];
#define GDN_LOAD(nn, J) do { const size_t cu = (size_t)((b * 128 + (nn)) * 4 + h); \
        const bf16_t* ap = (isq ? QKD + cu * 16384 : UW + cu * 16384 + 8192) + tt * 2048 + lane * 8; \
        _Pragma("unroll") for (int ks = 0; ks < 4; ++ks) A4[J][ks] = *(const pg8::bf16x8*)(ap + ks * 512); \
        const bf16_t* kp = QKD + cu * 16384 + 8192 + wv * 1024 + lane * 8; K2[J][0] = *(const pg8::bf16x8*)kp; K2[J][1] = *(const pg8::bf16x8*)(kp + 512); \
        if (isq) { const bf16_t* qp = QKB + cu * 4096 + tt * 1024 + lane * 8; Q2[J][0] = *(const pg8::bf16x8*)qp; Q2[J][1] = *(const pg8::bf16x8*)(qp + 512); } \
        else UU[J] = *(const uint2*)(UW + cu * 16384 + ((es * 4 + tt) * 64 + lane) * 4); \
        GL[J] = gates[(size_t)(b * 128 + (nn)) * 512 + 4 + h + zoff]; } while (0)
#pragma unroll
    for (int j = 0; j < 4; ++j) GDN_LOAD(j, j);
    for (int n0 = 0; n0 < 128; n0 += 4) {
#pragma unroll
        for (int j = 0; j < 4; ++j) {
            const int n = n0 + j;
            f32x4 acc = {0.f, 0.f, 0.f, 0.f};
#pragma unroll
            for (int ks = 0; ks < 4; ++ks) acc = __builtin_amdgcn_mfma_f32_16x16x32_bf16(A4[j][ks], *(const pg8::bf16x8*)(Sl + fr * 136 + ks * 32 + fq * 8), acc, 0, 0, 0);
            if (!isq) *(uint2*)(Vn + fr * 72 + tt * 16 + fq * 4) = pack4(lo_bf(UU[j].x) - acc[0], hi_bf(UU[j].x) - acc[1], lo_bf(UU[j].y) - acc[2], hi_bf(UU[j].y) - acc[3]);
            __syncthreads();
            const float cd = __expf(GL[j]);
            f32x4 sacc = S * cd;
#pragma unroll
            for (int ks = 0; ks < 2; ++ks) sacc = __builtin_amdgcn_mfma_f32_16x16x32_bf16(K2[j][ks], *(const pg8::bf16x8*)(Vn + fr * 72 + ks * 32 + fq * 8), sacc, 0, 0, 0);
            S = sacc;
            if (isq) {
#pragma unroll
                for (int ks = 0; ks < 2; ++ks) acc = __builtin_amdgcn_mfma_f32_16x16x32_bf16(Q2[j][ks], *(const pg8::bf16x8*)(Vn + fr * 72 + ks * 32 + fq * 8), acc, 0, 0, 0);
                bf16_t* op = Ot + (tt * 16 + fq * 4) * 16 + fr;
                op[0] = f2bf(acc[0]); op[16] = f2bf(acc[1]); op[32] = f2bf(acc[2]); op[48] = f2bf(acc[3]);
            }
            *(uint2*)(Sl + fr * 136 + wv * 16 + fq * 4) = pack4(S[0], S[1], S[2], S[3]);
            __syncthreads();
            if (tid < 128)
                *(u32x4*)(mix + ((size_t)(b * 128 + n) * 64 + es * 8 + (tid >> 4)) * 1024 + 256 + h * 128 + (tid & 15) * 8) = *(const u32x4*)(Ot + tid * 8);
            if (DRY != 1) { const int nx = DRY == 2 ? j : (n + 4 < 128 ? n + 4 : 127); GDN_LOAD(nx, j); }
        }
    }
#undef GDN_LOAD
}

#ifndef HGRN_NAIVE
#define HGRN_NAIVE 0
#endif
#ifndef LRU_NAIVE
#define LRU_NAIVE 0
#endif
__device__ void hgrn_naive(const Params& p, int l, int item) {
    const int lane = TID() & 63, dg = lane >> 4, e = lane & 15;
    const int b = item >> 4, h = (item >> 2) & 3, eg = item & 3, ce = h * 64 + eg * 16 + e;
    const bf16_t* proj = (const bf16_t*)(p.ws + WS_R); bf16_t* mix = (bf16_t*)(p.ws + WS_MIX);
    const float lb = lower_bound(p.in[I_LB], l, h * 64 + lane);
    float S[16];
#pragma unroll
    for (int i = 0; i < 16; ++i) S[i] = 0.f;
    const size_t tb = (size_t)b * SEQ;
    float fpn = bf2f(proj[tb * NP + C_AF + h * 64 + lane]), aqn = bf2f(proj[tb * NP + C_AQ + h * 64 + lane]), vn = bf2f(proj[tb * NP + C_AI + ce]);
    for (int t = 0; t < SEQ; ++t) {
        const float fp = fpn, aq = aqn, v = vn;
        {
            const size_t tok = tb + (t + 1 < SEQ ? t + 1 : t);
            fpn = bf2f(proj[tok * NP + C_AF + h * 64 + lane]); aqn = bf2f(proj[tok * NP + C_AQ + h * 64 + lane]); vn = bf2f(proj[tok * NP + C_AI + ce]);
        }
        const float sg = sigm(fp);
        const float f = fmaxf(lb + (1.f - lb) * sg, 1e-30f), k = (1.f - lb) * sigm(-fp), q = silu(aq);
        float o0 = 0.f, o1 = 0.f;
#pragma unroll
        for (int j = 0; j < 16; j += 2) {
            const int s0 = (lane & 48) | j, s1 = s0 + 1;
            const float f0 = __shfl(f, s0), kk0 = __shfl(k, s0), q0 = __shfl(q, s0), f1 = __shfl(f, s1), kk1 = __shfl(k, s1), q1 = __shfl(q, s1);
            S[j] = f0 * S[j] + kk0 * v; o0 += q0 * S[j];
            S[j + 1] = f1 * S[j + 1] + kk1 * v; o1 += q1 * S[j + 1];
        }
        float o = o0 + o1;
        o += __shfl_xor(o, 16); o += __shfl_xor(o, 32);
        if (dg == 0) mix[(tb + t) * 1024 + ce] = f2bf(o);
    }
}
__device__ void lru_naive(const Params& p, int l, int item) {
    const int lane = TID() & 63, b = item >> 2, c = (item & 3) * 64 + lane;
    const bf16_t* proj = (const bf16_t*)(p.ws + WS_R); const bf16_t* Z = (const bf16_t*)(p.ws + WS_Z); bf16_t* mix = (bf16_t*)(p.ws + WS_MIX);
    const float* lcw = p.in[I_LCW] + (size_t)l * 4 * 256 + c;
    const float w0 = lcw[0], w1 = lcw[256], w2 = lcw[512], w3 = lcw[768], cb = p.in[I_LCB][l * 256 + c];
    const float sp = softplus(-p.in[I_LLAM][l * 256 + c]);
    float x0 = 0.f, x1 = 0.f, x2 = 0.f, hst = 0.f;
    const size_t tb = (size_t)b * SEQ;
    float xn = bf2f(proj[tb * NP + C_CX + c]), yn = bf2f(proj[tb * NP + C_CY + c]), zrn = bf2f(Z[tb * 512 + c]), zin = bf2f(Z[tb * 512 + 256 + c]);
    for (int t = 0; t < SEQ; ++t) {
        const float x3 = xn, y = yn, zr = zrn, zi = zin;
        {
            const size_t tok = tb + (t + 1 < SEQ ? t + 1 : t);
            xn = bf2f(proj[tok * NP + C_CX + c]); yn = bf2f(proj[tok * NP + C_CY + c]); zrn = bf2f(Z[tok * 512 + c]); zin = bf2f(Z[tok * 512 + 256 + c]);
        }
        const float xc = w0 * x0 + w1 * x1 + w2 * x2 + w3 * x3 + cb;
        x0 = x1; x1 = x2; x2 = x3;
        const float r = sigm(zr), ig = sigm(zi);
        const float log_a = -8.f * r * sp, a = __expf(log_a);
        const float mult = (t == 0) ? 1.f : sqrtf(fmaxf(-expm1f(2.f * log_a), EPS));
        hst = a * hst + mult * ig * xc;
        mix[(tb + t) * 1024 + 768 + c] = f2bf(gelu_tanh(y) * hst);
    }
}
__device__ unsigned g_bar[1024];
__device__ __forceinline__ unsigned xcc_id() { return (unsigned)__builtin_amdgcn_s_getreg((3 << 11) | 20) & 0xFu; }
__device__ __forceinline__ void grid_barrier(unsigned epoch, unsigned n_x, unsigned n_xcd, unsigned base_x, unsigned base_g) {
    asm volatile("s_waitcnt vmcnt(0) lgkmcnt(0)" ::: "memory");
    __syncthreads();
    if (threadIdx.x == 0) {
        const unsigned x = xcc_id() & 7u;
        const unsigned old = __hip_atomic_fetch_add(&g_bar[x * 64], 1u, __ATOMIC_RELAXED, __HIP_MEMORY_SCOPE_AGENT);
        if (old + 1u - base_x == epoch * n_x) {
            __builtin_amdgcn_fence(__ATOMIC_RELEASE, "agent");
            __hip_atomic_fetch_add(&g_bar[512], 1u, __ATOMIC_RELAXED, __HIP_MEMORY_SCOPE_AGENT);
        }
        while (__hip_atomic_load(&g_bar[512], __ATOMIC_RELAXED, __HIP_MEMORY_SCOPE_AGENT) - base_g < epoch * n_xcd) __builtin_amdgcn_s_sleep(1);
        __builtin_amdgcn_fence(__ATOMIC_ACQUIRE, "agent");
    }
    __syncthreads();
}
__device__ __forceinline__ void sub_barrier(unsigned epoch, unsigned n, unsigned base) {
    asm volatile("s_waitcnt vmcnt(0) lgkmcnt(0)" ::: "memory");
    __syncthreads();
    if (threadIdx.x == 0) {
        __builtin_amdgcn_fence(__ATOMIC_RELEASE, "agent");
        __hip_atomic_fetch_add(&g_bar[640], 1u, __ATOMIC_RELAXED, __HIP_MEMORY_SCOPE_AGENT);
        while (__hip_atomic_load(&g_bar[640], __ATOMIC_RELAXED, __HIP_MEMORY_SCOPE_AGENT) - base < epoch * n) __builtin_amdgcn_s_sleep(1);
        __builtin_amdgcn_fence(__ATOMIC_ACQUIRE, "agent");
    }
    __syncthreads();
}
__device__ void phase_m1(const Params& p, int l, unsigned char* smem) {
    {
        u32x4 pq[3], pk[3], pv[3]; const bf16_t* proj = (const bf16_t*)(p.ws + WS_R);
        if (PROBE_DUP & 1) { gdn_raw_load(proj, BID(), 0, TID(), pq); gdn_raw_load(proj, BID(), 1, TID(), pk); gdn_raw_load(proj, BID(), 2, TID(), pv);
            for (int u = BID(); u < 2048; u += gridDim.x) gdn_unit_m1(p, l, u, u + (int)gridDim.x, pq, pk, pv, smem, false); }
        gdn_raw_load(proj, BID(), 0, TID(), pq); gdn_raw_load(proj, BID(), 1, TID(), pk); gdn_raw_load(proj, BID(), 2, TID(), pv);
        for (int u = BID(); u < 2048; u += gridDim.x) gdn_unit_m1(p, l, u, u + (int)gridDim.x, pq, pk, pv, smem);
    }
    lru_load_wt(p, l, smem);
    if (PROBE_DUP & 128) for (int u = BID(); u < 512; u += gridDim.x) lru_unit_a(p, l, u, smem);
    for (int u = BID(); u < 512; u += gridDim.x) lru_unit_a(p, l, u, smem);
    __syncthreads();
    float* lbs = (float*)(smem + 120 * 1024);
    if (TID() < 256) lbs[TID()] = lower_bound(p.in[I_LB], l, TID());
    __syncthreads();
    if (!HGRN_NAIVE) { u32x4 hp[3]; hgrn_load(p, BID(), TID(), hp);
        for (int u = BID(); u < 2048; u += gridDim.x) hgrn_unit<false>(p, l, u, u + (int)gridDim.x, hp, smem, lbs); }
}
#ifndef HG_SPLIT
#define HG_SPLIT 2048
#endif
__device__ void phase_m2(const Params& p, int l, unsigned char* smem, unsigned sub_base) {
    const int bid = BID(), tid = TID();
    if (bid < 128) { const int item = (((bid & 7) * 2 + (bid >> 6)) << 3) | ((bid >> 3) & 7);
        if (PROBE_DUP & 2) gdn_seq<0>(p, l, item, smem); if (PROBE_DUP & 16) gdn_seq<1>(p, l, item, smem); if (PROBE_DUP & 32) gdn_seq<2>(p, l, item, smem); gdn_seq<0>(p, l, item, smem); return; }
    const int hb = bid - 128, nhb = gridDim.x - 128;
    if (HGRN_NAIVE && hb < 64 && tid < 64) hgrn_naive(p, l, hb);
    if (LRU_NAIVE && hb >= 64 && hb < 80 && tid < 64) lru_naive(p, l, hb - 64);
    if (!HGRN_NAIVE && tid < 128) { for (int gt = hb * 128 + tid; gt < 16384; gt += nhb * 128) hgrn_scan(p, gt); }
    else if (!LRU_NAIVE && tid >= 128 && tid < 192) { for (int gt = hb * 64 + (tid - 128); gt < 1024; gt += nhb * 64) lru_carry(p, gt); }
    sub_barrier((unsigned)(l + 1), (unsigned)nhb, sub_base);
    {
        float* lbs = (float*)(smem + 120 * 1024);
        if (tid < 256) lbs[tid] = lower_bound(p.in[I_LB], l, tid);
        __syncthreads();
        { u32x4 hp[3]; hgrn_load(p, hb, tid, hp);
          for (int u = hb; u < HG_SPLIT; u += nhb) hgrn_unit<true>(p, l, u, (u + nhb < HG_SPLIT) ? u + nhb : 4096, hp, smem, lbs); }
        __syncthreads();
    }
}

__device__ void phase_m3(const Params& p, int l, unsigned char* smem) {
    const int tid = TID(), lane = tid & 63, wv = tid >> 6;
    const bf16_t* proj = (const bf16_t*)(p.ws + WS_R); bf16_t* mix = (bf16_t*)(p.ws + WS_MIX);
    {
        float* ssx = (float*)smem;
        const int r = tid >> 3, es = r >> 3, t = (r & 7) * 8 + (tid & 7);
        const int kstep = (int)(gridDim.x >> 3);
        u32x4 nv0, nv1, nz0, nz1;
        {
            const int k = BID() >> 3, pair = (BID() & 7) * 2 + (k >> 7), u = (((pair >> 2) * 128 + (k & 127)) << 2) | (pair & 3); const size_t tk0 = (size_t)(u >> 2) * 64;
            if (k < 256) { const u32x4* s_ = (const u32x4*)(mix + (tk0 + r) * 1024 + 256 + (u & 3) * 128 + (tid & 7) * 16); nv0 = s_[0]; nv1 = s_[1];
                const u32x4* z_ = (const u32x4*)(proj + (tk0 + t) * NP + C_BZ + (u & 3) * 128 + es * 16); nz0 = z_[0]; nz1 = z_[1]; }
        }
        for (int k = BID() >> 3; k < 256; k += kstep) {
            const int pair = (BID() & 7) * 2 + (k >> 7), n_ = k & 127, u = (((pair >> 2) * 128 + n_) << 2) | (pair & 3);
            const int h = u & 3; const size_t tok0 = (size_t)(u >> 2) * 64;
            const u32x4 v0 = nv0, v1 = nv1, z0 = nz0, z1 = nz1;
            if (k + kstep < 256) {
                const int k2 = k + kstep, pair2 = (BID() & 7) * 2 + (k2 >> 7), u2 = (((pair2 >> 2) * 128 + (k2 & 127)) << 2) | (pair2 & 3); const size_t tk2 = (size_t)(u2 >> 2) * 64;
                const u32x4* s_ = (const u32x4*)(mix + (tk2 + r) * 1024 + 256 + (u2 & 3) * 128 + (tid & 7) * 16); nv0 = s_[0]; nv1 = s_[1];
                const u32x4* z_ = (const u32x4*)(proj + (tk2 + t) * NP + C_BZ + (u2 & 3) * 128 + es * 16); nz0 = z_[0]; nz1 = z_[1];
            }
            float o[16] = {lo_bf(v0.x), hi_bf(v0.x), lo_bf(v0.y), hi_bf(v0.y), lo_bf(v0.z), hi_bf(v0.z), lo_bf(v0.w), hi_bf(v0.w), lo_bf(v1.x), hi_bf(v1.x), lo_bf(v1.y), hi_bf(v1.y), lo_bf(v1.z), hi_bf(v1.z), lo_bf(v1.w), hi_bf(v1.w)};
            float sq = 0.f;
#pragma unroll
            for (int j = 0; j < 16; ++j) sq += o[j] * o[j];
            __syncthreads();
            ssx[es * 64 + t] = sq;
            __syncthreads();
            float tot = 0.f;
#pragma unroll
            for (int k8 = 0; k8 < 8; ++k8) tot += ssx[k8 * 64 + t];
            const float rr = rsqrtf(tot * (1.f / 128.f) + EPS);
            const float zz[16] = {lo_bf(z0.x), hi_bf(z0.x), lo_bf(z0.y), hi_bf(z0.y), lo_bf(z0.z), hi_bf(z0.z), lo_bf(z0.w), hi_bf(z0.w), lo_bf(z1.x), hi_bf(z1.x), lo_bf(z1.y), hi_bf(z1.y), lo_bf(z1.z), hi_bf(z1.z), lo_bf(z1.w), hi_bf(z1.w)};
            const float* g = p.in[I_GNG] + l * 128 + es * 16;
            float y[16];
#pragma unroll
            for (int j = 0; j < 16; ++j) y[j] = o[j] * rr * g[j] * silu(zz[j]);
            u32x4 w0, w1;
            w0.x = cvt_pk_bf16(y[0], y[1]); w0.y = cvt_pk_bf16(y[2], y[3]); w0.z = cvt_pk_bf16(y[4], y[5]); w0.w = cvt_pk_bf16(y[6], y[7]);
            w1.x = cvt_pk_bf16(y[8], y[9]); w1.y = cvt_pk_bf16(y[10], y[11]); w1.z = cvt_pk_bf16(y[12], y[13]); w1.w = cvt_pk_bf16(y[14], y[15]);
            u32x4* dst = (u32x4*)(mix + (tok0 + t) * 1024 + 256 + h * 128 + es * 16);
            dst[0] = w0; dst[1] = w1;
        }
        __syncthreads();
    }
    for (int u0 = BID() * 2; u0 < 512; u0 += gridDim.x * 2) lru_unit_c(p, l, u0 + (tid >> 8), tid & 255);
    __syncthreads();
    {
    float* tile = (float*)smem;
    convert_w(p.in[I_WOUT] + (size_t)l * DM * DM, DM, 0, nullptr, (bf16_t*)(p.ws + WS_WOUT), DM, DM, tile, BID(), (int)gridDim.x);
    convert_w(p.in[I_WUP] + (size_t)l * DM * DFF, DFF, 0, p.in[I_N2G] + l * DM, (bf16_t*)(p.ws + WS_WUP), DFF, DM, tile, BID(), (int)gridDim.x);
    convert_w(p.in[I_WDN] + (size_t)l * DFF * DM, DM, 0, nullptr, (bf16_t*)(p.ws + WS_WDN), DM, DFF, tile, BID(), (int)gridDim.x);
    if (l + 1 < DEPTH) convert_w(p.in[I_WIN] + (size_t)(l + 1) * DM * DIN, DIN, 1, p.in[I_N1G] + (l + 1) * DM, (bf16_t*)(p.ws + WS_WIN), NP, DM, tile, BID(), (int)gridDim.x);
    }
    if (HG_SPLIT < 2048) {
        __syncthreads();
        float* lbs = (float*)(smem + 120 * 1024);
        if (tid < 256) lbs[tid] = lower_bound(p.in[I_LB], l, tid);
        __syncthreads();
        { u32x4 hp[3]; if (HG_SPLIT + BID() < 2048) hgrn_load(p, HG_SPLIT + BID(), tid, hp);
          for (int u = HG_SPLIT + BID(); u < 2048; u += gridDim.x) hgrn_unit<true>(p, l, u, u + (int)gridDim.x, hp, smem, lbs); }
    }
}

__device__ void phase_final(const Params& p) {
    const int tid = TID(), lane = tid & 63, gw = BID() * 8 + (tid >> 6), nw = gridDim.x * 8;
    const float* ss = (const float*)(p.ws + WS_SS); const float* g = p.in[I_FNG];
    f32x4 gv[4];
#pragma unroll
    for (int i = 0; i < 4; ++i) gv[i] = *(const f32x4*)(g + (i * 64 + lane) * 4);
    for (int row0 = gw; row0 < T; row0 += 4 * nw) {
        f32x4 v[4][4]; float rs[4];
#pragma unroll
        for (int r = 0; r < 4; ++r) { const int row = row0 + r * nw < T ? row0 + r * nw : row0;
            rs[r] = row_rstd(ss, row);
#pragma unroll
            for (int i = 0; i < 4; ++i) v[r][i] = *(const f32x4*)(p.out + (size_t)row * 1024 + (i * 64 + lane) * 4); }
#pragma unroll
        for (int r = 0; r < 4; ++r) { const int row = row0 + r * nw;
            if (row < T) {
#pragma unroll
                for (int i = 0; i < 4; ++i) *(f32x4*)(p.out + (size_t)row * 1024 + (i * 64 + lane) * 4) = v[r][i] * rs[r] * gv[i]; } }
    }
}

constexpr int N_PHASES = 2 + 7 * DEPTH;
__device__ __forceinline__ void run_phase(const Params& p, int ph, unsigned char* smem, unsigned sub_base) {
    if (ph == 0) { phase_init(p, smem); return; }
    if (ph == N_PHASES - 1) { phase_final(p); return; }
    const int l = (ph - 1) / 7, k = (ph - 1) % 7;
    PG8_LAS unsigned char* lds = (PG8_LAS unsigned char*)smem;
    float* ss = (float*)(p.ws + WS_SS);
    pg8::StaticOrder S;
    if (k == 0) {
        pg8::Gemm g{(const bf16_t*)(p.ws + WS_XB), (const bf16_t*)(p.ws + WS_WIN), T, NP, DM}; S.init(T, NP, gridDim.x, BID());
        EpiScaled<0> E{(bf16_t*)(p.ws + WS_R), NP, ss};
        if (PROBE_DUP & 8) pg8::gemm_phase<EpiScaled<0>, pg8::StaticOrder, true, true>(lds, g, S, E);
        pg8::gemm_phase<EpiScaled<0>, pg8::StaticOrder, true, true>(lds, g, S, E);
        if (PROBE_DUP & 128) phase_gates(p, l, smem);
        phase_gates(p, l, smem);
    } else if (k == 1) phase_m1(p, l, smem);
    else if (k == 2) phase_m2(p, l, smem, sub_base);
    else if (k == 3) phase_m3(p, l, smem);
    else if (k == 4 || k == 6) {
        pg8::Gemm g{(const bf16_t*)(p.ws + (k == 4 ? WS_MIX : WS_R)), (const bf16_t*)(p.ws + (k == 4 ? WS_WOUT : WS_WDN)), T, DM, k == 4 ? DM : DFF}; S.init(T, DM, gridDim.x, BID());
        EpiResid E{(l == 0 && k == 4) ? p.in[I_X] : (const float*)p.out, p.out, (bf16_t*)(p.ws + WS_XB), ss + (size_t)(k == 4 ? 1 : 0) * T * 16};
        pg8::gemm_phase<EpiResid, pg8::StaticOrder, true, true>(lds, g, S, E);
    } else {
        pg8::Gemm g{(const bf16_t*)(p.ws + WS_XB), (const bf16_t*)(p.ws + WS_WUP), T, DFF, DM}; S.init(T, DFF, gridDim.x, BID());
        EpiScaled<1> E{(bf16_t*)(p.ws + WS_R), DFF, ss + (size_t)T * 16};
        if (PROBE_DUP & 256) pg8::gemm_phase<EpiScaled<1>, pg8::StaticOrder, true, true>(lds, g, S, E);
        pg8::gemm_phase<EpiScaled<1>, pg8::StaticOrder, true, true>(lds, g, S, E);
    }
}

#ifndef MK_COOP
#define MK_COOP 1
#endif
__global__ __launch_bounds__(512, 2) void mk_fwd(Params p, int ph_lo, int ph_hi) {
    extern __shared__ __attribute__((aligned(16))) unsigned char shm[];
    unsigned bar_epoch = 0, bar_nx = 0, bar_nxcd = 0;
    const unsigned my_xcc = xcc_id() & 7u;
    const unsigned bar_bx = __hip_atomic_load(&g_bar[my_xcc * 64], __ATOMIC_RELAXED, __HIP_MEMORY_SCOPE_AGENT), bar_bg = __hip_atomic_load(&g_bar[512], __ATOMIC_RELAXED, __HIP_MEMORY_SCOPE_AGENT), bar_bs = __hip_atomic_load(&g_bar[640], __ATOMIC_RELAXED, __HIP_MEMORY_SCOPE_AGENT);
    if (MK_COOP && threadIdx.x == 0) ((unsigned*)(p.ws + WS_Z))[blockIdx.x] = my_xcc;
    for (int ph = ph_lo; ph < ph_hi; ++ph) {
        const __attribute__((address_space(4))) Params* pp = (const __attribute__((address_space(4))) Params*)__builtin_amdgcn_kernarg_segment_ptr();
        asm volatile("" : "+s"(pp));
        Params q;
#pragma unroll
        for (int i = 0; i < 21; ++i) q.in[i] = pp->in[i];
        q.out = pp->out; q.ws = pp->ws;
        run_phase(q, ph, shm, bar_bs);
#if MK_COOP
        if (ph + 1 < ph_hi) {
            if (ph == ph_lo) {
                asm volatile("s_waitcnt vmcnt(0) lgkmcnt(0)" ::: "memory"); __syncthreads(); cg::this_grid().sync();
                unsigned seen = 0u;
                for (unsigned i = 0; i < gridDim.x; ++i) { const unsigned v = __hip_atomic_load((unsigned*)(p.ws + WS_Z) + i, __ATOMIC_RELAXED, __HIP_MEMORY_SCOPE_AGENT) & 7u; bar_nx += (v == my_xcc) ? 1u : 0u; seen |= 1u << v; }
                bar_nxcd = (unsigned)__builtin_popcount(seen);
            } else grid_barrier(++bar_epoch, bar_nx, bar_nxcd, bar_bx, bar_bg);
        }
#endif
    }
}

extern "C" void kernel_launch(void* const* d_in, const int* in_sizes, int n_in, void* d_out, int out_size, void* d_ws, size_t ws_size, hipStream_t stream) {
    static int grid = 0;
    constexpr int LDS_BYTES = 131072;
    if (grid == 0) {
        if (n_in != 21 || out_size != T * DM || ws_size < WS_END) { fprintf(stderr, "kernel_launch: unexpected shapes (n_in %d out %d ws %zu)\n", n_in, out_size, ws_size); grid = -1; return; }
        int dev = 0, cus = 0, per_cu = 0;
        hipGetDevice(&dev); hipDeviceGetAttribute(&cus, hipDeviceAttributeMultiprocessorCount, dev);
        if (hipFuncSetAttribute((const void*)mk_fwd, hipFuncAttributeMaxDynamicSharedMemorySize, LDS_BYTES) != hipSuccess) { fprintf(stderr, "kernel_launch: hipFuncSetAttribute failed\n"); grid = -1; return; }
        if (hipOccupancyMaxActiveBlocksPerMultiprocessor(&per_cu, (const void*)mk_fwd, 512, LDS_BYTES) != hipSuccess || per_cu < 1) { fprintf(stderr, "kernel_launch: occupancy query gave %d\n", per_cu); per_cu = 1; }
        (void)hipGetLastError();
        grid = cus * 1;
    }
    if (grid < 0) return;
    Params p{};
    for (int i = 0; i < 21; ++i) p.in[i] = (const float*)d_in[i];
    p.out = (float*)d_out; p.ws = (unsigned char*)d_ws;
#if MK_COOP
    int lo = 0, hi = N_PHASES;
    void* args[] = {&p, &lo, &hi};
    hipError_t e = hipLaunchCooperativeKernel((const void*)mk_fwd, dim3(grid), dim3(512), args, LDS_BYTES, stream);
    if (e != hipSuccess) fprintf(stderr, "cooperative launch failed: %s (grid %d)\n", hipGetErrorString(e), grid);
#else
    for (int ph = 0; ph < N_PHASES; ++ph) hipLaunchKernelGGL(mk_fwd, dim3(grid), dim3(512), LDS_BYTES, stream, p, ph, ph + 1);
#endif
}
```

```cpp
#include <hip/hip_runtime.h>
#include <hip/hip_cooperative_groups.h>
#include <cstdio>
namespace cg = cooperative_groups;
namespace pg8 {
#define PG8_LAS __attribute__((address_space(3)))
typedef unsigned short bf16_t;
typedef short bf16x8 __attribute__((ext_vector_type(8)));
typedef float f32x4 __attribute__((ext_vector_type(4)));
typedef unsigned u32x4 __attribute__((ext_vector_type(4)));
constexpr int BM = 256, BK = 64, HALF = 128, HTB = HALF * BK * 2  , STAGE_BYTES = 8 * HTB, NXCD = 8, WGM = 8;

__host__ __device__ __forceinline__ int lds_byte(int r, int c) { const int st = (r >> 4) * 2 + (c >> 5), rr = r & 15, cc = c & 31, ob = rr * 64 + cc * 2; return st * 1024 + (ob ^ (((ob >> 9) & 1) << 5)); }
__host__ __device__ __forceinline__ void stage_rc(int b, int& R, int& C) { const int st = b / 1024, sb = b % 1024, swz = sb ^ (((sb >> 9) & 1) << 5); R = (st >> 1) * 16 + swz / 64; C = (st & 1) * 32 + (swz % 64) / 2; }
__host__ __device__ __forceinline__ int perm32(int rho) { const int n = rho >> 4, i = rho & 15; return 8 * (i >> 2) + 4 * n + (i & 3); }

struct Unit { int pm, pn; };
struct Gemm { const bf16_t* A; const bf16_t* Bt; int M, N, K; };

struct StaticOrder {
    int nM, nN, nwg, G, c;
    __host__ __device__ void init(int M, int N, int G_, int c_) { nM = M / BM; nN = N / BM; nwg = nM * nN; G = G_; c = c_; }
    __host__ __device__ bool next(int i, Unit& u) const {
        const long L = (long)i * G + c; if (L >= nwg) return false;
        int wgid = (int)L; { const int q = nwg / NXCD, r = nwg % NXCD, xcd = wgid % NXCD, off = wgid / NXCD; wgid = (xcd < r ? xcd * (q + 1) : r * (q + 1) + (xcd - r) * q) + off; }
        const int nig = WGM * nN, gid = wgid / nig, fm = gid * WGM, gsz = (nM - fm) < WGM ? (nM - fm) : WGM;
        u.pm = fm + ((wgid % nig) % gsz); u.pn = (wgid % nig) / gsz; return true;
    }
    __device__ __forceinline__ void a_ready(const Unit&) const {}
    __device__ __forceinline__ void done(const Unit&) const {}
};
__device__ __forceinline__ unsigned cvt_pk_bf16(float lo, float hi) { unsigned r; asm volatile("v_cvt_pk_bf16_f32 %0, %1, %2" : "=v"(r) : "v"(lo), "v"(hi)); return r; }
__device__ __forceinline__ int TID() { int t = threadIdx.x; asm volatile("" : "+v"(t)); return t; }
__device__ __forceinline__ int BID() { int t = blockIdx.x; asm volatile("" : "+s"(t)); return t; }
template <class Epi, class Sched, bool ALIGN_EPI = false, bool SP2 = false>
__device__ __forceinline__ void gemm_phase(PG8_LAS unsigned char* lds, const Gemm g, const Sched& S, const Epi& E) {
    const int tid = TID(), wid = __builtin_amdgcn_readfirstlane(tid >> 6), lane = tid & 63, wr = wid >> 2, wc = wid & 3, fr = lane & 15, fq = lane >> 4;
    const int K = g.K, nt = K / BK;
    unsigned voffA[2], voffB[2];
#pragma unroll
    for (int i = 0; i < 2; ++i) { int R, C; stage_rc(tid * 16 + i * 8192, R, C); const int Rb = Epi::PERM ? ((R & ~31) + perm32(R & 31)) : R;
        voffA[i] = (unsigned)(R * K + C) * 2u; voffB[i] = (unsigned)(Rb * K + C) * 2u; }
    const size_t kstep = (size_t)(BK * 2);
    const size_t hstep = (size_t)HALF * K * 2;
    const size_t tstep = 2 * hstep;
    const unsigned ldsw = (unsigned)wid * 1024u;
    const int aoff = lds_byte(wr * 64 + fr, fq * 8), boff = lds_byte(wc * 32 + fr, fq * 8);
#define PG8_SA(b, h) (((b) * 2 + (h)) * HTB)
#define PG8_SB(b, h) ((4 + (b) * 2 + (h)) * HTB)
#define PG8_STAGE(bufoff, gbase, voff) do { _Pragma("unroll") for (int _i = 0; _i < 2; ++_i) \
        __builtin_amdgcn_global_load_lds((const unsigned*)((const char*)(gbase) + (voff)[_i]), (PG8_LAS unsigned*)(lds + (bufoff) + ldsw + _i * 8192), 16, 0, 0); } while (0)
#define PG8_LDA(dst, b, h) do { _Pragma("unroll") for (int m = 0; m < 4; ++m) _Pragma("unroll") for (int k = 0; k < 2; ++k) dst[m][k] = *(const PG8_LAS bf16x8*)(lds + PG8_SA(b, h) + aoff + m * 2048 + k * 1024); } while (0)
#define PG8_LDB(dst, b, h) do { _Pragma("unroll") for (int n = 0; n < 2; ++n) _Pragma("unroll") for (int k = 0; k < 2; ++k) dst[n][k] = *(const PG8_LAS bf16x8*)(lds + PG8_SB(b, h) + boff + n * 2048 + k * 1024); } while (0)
#define PG8_MMA(ai, bj, At, Bt) do { __builtin_amdgcn_s_setprio(1); _Pragma("unroll") for (int m = 0; m < 4; ++m) _Pragma("unroll") for (int n = 0; n < 2; ++n) _Pragma("unroll") for (int k = 0; k < 2; ++k) \
        acc[ai][bj][m][n] = __builtin_amdgcn_mfma_f32_16x16x32_bf16(Bt[n][k], At[m][k], acc[ai][bj][m][n], 0, 0, 0); __builtin_amdgcn_s_setprio(0); } while (0)
#define PG8_WAIT_V(n) asm volatile("s_waitcnt vmcnt(" #n ")" ::: "memory")
#define PG8_WAIT_L(n) asm volatile("s_waitcnt lgkmcnt(" #n ")" ::: "memory")
#define PG8_BAR __builtin_amdgcn_s_barrier()
#define PG8_SCHED __builtin_amdgcn_sched_barrier(0)
    Unit cur, nxt; int ui = 0;
    if (!S.next(0, cur)) return;
    f32x4 acc[2][2][4][2];
#pragma unroll
    for (int a = 0; a < 2; ++a)
#pragma unroll
        for (int b = 0; b < 2; ++b)
#pragma unroll
            for (int m = 0; m < 4; ++m)
#pragma unroll
                for (int n = 0; n < 2; ++n) acc[a][b][m][n] = (f32x4){0.f, 0.f, 0.f, 0.f};
    bf16x8 At[4][2], B0[2][2], B1[2][2];
    const char* cA = (const char*)g.A + (size_t)cur.pm * tstep; const char* cB = (const char*)g.Bt + (size_t)cur.pn * tstep;
    S.a_ready(cur);
    if constexpr (SP2) {
        PG8_STAGE(PG8_SB(0, 0), cB, voffB); PG8_STAGE(PG8_SB(0, 1), cB + hstep, voffB); PG8_STAGE(PG8_SA(0, 0), cA, voffA); PG8_STAGE(PG8_SA(0, 1), cA + hstep, voffA);
        if (wr == 1) PG8_BAR;
        PG8_WAIT_V(2); PG8_BAR;
        PG8_STAGE(PG8_SB(1, 0), cB + kstep, voffB); PG8_STAGE(PG8_SA(1, 0), cA + kstep, voffA); PG8_STAGE(PG8_SB(1, 1), cB + hstep + kstep, voffB);
        PG8_WAIT_V(6); PG8_BAR;
    } else {
        PG8_STAGE(PG8_SB(0, 0), cB, voffB); PG8_STAGE(PG8_SA(0, 0), cA, voffA); PG8_STAGE(PG8_SB(0, 1), cB + hstep, voffB); PG8_STAGE(PG8_SA(0, 1), cA + hstep, voffA);
        if (wr == 1) PG8_BAR;
        PG8_WAIT_V(4); PG8_BAR;
        PG8_STAGE(PG8_SB(1, 0), cB + kstep, voffB); PG8_STAGE(PG8_SA(1, 0), cA + kstep, voffA); PG8_STAGE(PG8_SB(1, 1), cB + hstep + kstep, voffB);
        PG8_WAIT_V(6); PG8_BAR;
    }
    for (;;) {
        const bool has_next = S.next(ui + 1, nxt);
        const char* nA = has_next ? (const char*)g.A + (size_t)nxt.pm * tstep : cA; const char* nB = has_next ? (const char*)g.Bt + (size_t)nxt.pn * tstep : cB;
        for (int t = 0; t < nt; t += 2) {
            const bool last = (t == nt - 2);
            const char* a1 = cA + (size_t)(t + 1) * kstep;
            const char* a2 = last ? nA : cA + (size_t)(t + 2) * kstep; const char* b2 = last ? nB : cB + (size_t)(t + 2) * kstep;
            const char* a3 = a2 + kstep; const char* b3 = b2 + kstep;
            if (last && has_next) S.a_ready(nxt);
            if constexpr (SP2) {
            PG8_LDB(B0, 0, 0); PG8_LDB(B1, 0, 1); PG8_SCHED; PG8_LDA(At, 0, 0); PG8_STAGE(PG8_SA(1, 1), a1 + hstep, voffA);
            PG8_WAIT_V(8); PG8_WAIT_L(0); PG8_BAR; PG8_MMA(0, 0, At, B0); PG8_MMA(0, 1, At, B1); PG8_BAR; PG8_SCHED;
            PG8_LDA(At, 0, 1); PG8_STAGE(PG8_SB(0, 0), b2, voffB); PG8_STAGE(PG8_SB(0, 1), b2 + hstep, voffB); PG8_STAGE(PG8_SA(0, 0), a2, voffA);
            PG8_WAIT_V(8); PG8_WAIT_L(0); PG8_BAR; PG8_MMA(1, 0, At, B0); PG8_MMA(1, 1, At, B1); PG8_BAR; PG8_SCHED;
            PG8_LDB(B0, 1, 0); PG8_LDB(B1, 1, 1); PG8_SCHED; PG8_LDA(At, 1, 0); PG8_STAGE(PG8_SA(0, 1), a2 + hstep, voffA);
            PG8_WAIT_V(8); PG8_WAIT_L(0); PG8_BAR; PG8_MMA(0, 0, At, B0); PG8_MMA(0, 1, At, B1); PG8_BAR; PG8_SCHED;
            PG8_LDA(At, 1, 1); PG8_STAGE(PG8_SB(1, 0), b3, voffB); PG8_STAGE(PG8_SB(1, 1), b3 + hstep, voffB); PG8_STAGE(PG8_SA(1, 0), a3, voffA);
            PG8_WAIT_V(8); PG8_WAIT_L(0); PG8_BAR; PG8_MMA(1, 0, At, B0); PG8_MMA(1, 1, At, B1); PG8_BAR; PG8_SCHED;
            } else {
            PG8_LDB(B0, 0, 0); PG8_SCHED; PG8_LDA(At, 0, 0); PG8_STAGE(PG8_SA(1, 1), a1 + hstep, voffA);
            PG8_WAIT_L(8); PG8_BAR; PG8_WAIT_L(0); PG8_MMA(0, 0, At, B0); PG8_BAR; PG8_SCHED;
            PG8_LDB(B1, 0, 1); PG8_STAGE(PG8_SB(0, 0), b2, voffB);
            PG8_BAR; PG8_WAIT_L(0); PG8_MMA(0, 1, At, B1); PG8_BAR;
            PG8_LDA(At, 0, 1); PG8_STAGE(PG8_SA(0, 0), a2, voffA);
            PG8_BAR; PG8_WAIT_L(0); PG8_MMA(1, 0, At, B0); PG8_BAR; PG8_SCHED;
            PG8_STAGE(PG8_SB(0, 1), b2 + hstep, voffB);
            PG8_WAIT_V(6); PG8_BAR; PG8_MMA(1, 1, At, B1); PG8_BAR;
            PG8_LDB(B0, 1, 0); PG8_SCHED; PG8_LDA(At, 1, 0); PG8_STAGE(PG8_SA(0, 1), a2 + hstep, voffA);
            PG8_WAIT_L(8); PG8_BAR; PG8_WAIT_L(0); PG8_MMA(0, 0, At, B0); PG8_BAR; PG8_SCHED;
            PG8_LDB(B1, 1, 1); PG8_STAGE(PG8_SB(1, 0), b3, voffB);
            PG8_BAR; PG8_WAIT_L(0); PG8_MMA(0, 1, At, B1); PG8_BAR;
            PG8_LDA(At, 1, 1); PG8_STAGE(PG8_SA(1, 0), a3, voffA);
            PG8_BAR; PG8_WAIT_L(0); PG8_MMA(1, 0, At, B0); PG8_BAR; PG8_SCHED;
            PG8_STAGE(PG8_SB(1, 1), b3 + hstep, voffB);
            PG8_WAIT_V(6); PG8_BAR; PG8_MMA(1, 1, At, B1); PG8_BAR;
            }
        }
        if constexpr (ALIGN_EPI) { if (wr == 0) PG8_BAR; }
        if constexpr (!Epi::AFTER_DRAIN) { E(acc, cur, wr, wc, fr, fq); S.done(cur); }
        if (!has_next) break;
#pragma unroll
        for (int a = 0; a < 2; ++a)
#pragma unroll
            for (int b = 0; b < 2; ++b)
#pragma unroll
                for (int m = 0; m < 4; ++m)
#pragma unroll
                    for (int n = 0; n < 2; ++n) acc[a][b][m][n] = (f32x4){0.f, 0.f, 0.f, 0.f};
        cur = nxt; cA = nA; cB = nB; ++ui;
        if constexpr (ALIGN_EPI) { if (wr == 1) PG8_BAR; }
    }
    PG8_WAIT_V(0);
    if constexpr (!ALIGN_EPI) { if (wr == 0) PG8_BAR; }
    PG8_BAR;
    if constexpr (Epi::AFTER_DRAIN) { E.fused(acc, cur, wr, wc, fr, fq, lds, wid, lane); S.done(cur); }
#undef PG8_SA
#undef PG8_SB
#undef PG8_STAGE
#undef PG8_LDA
#undef PG8_LDB
#undef PG8_MMA
#undef PG8_WAIT_V
#undef PG8_WAIT_L
#undef PG8_BAR
#undef PG8_SCHED
}
}

using pg8::TID; using pg8::BID; using pg8::bf16_t; using pg8::f32x4; using pg8::u32x4; using pg8::cvt_pk_bf16;
constexpr int T = 32768, SEQ = 8192, DM = 1024, DIN = 3592, NP = 3584, DFF = 4096, DEPTH = 4;
constexpr float EPS = 1e-6f;
constexpr size_t MiB = (size_t)1 << 20;
constexpr size_t WS_XB = 0, WS_WIN = 64 * MiB, WS_WOUT = 71 * MiB, WS_WUP = 73 * MiB, WS_WDN = 81 * MiB, WS_R = 89 * MiB, WS_Z = WS_R + 224 * MiB, WS_HS = 480 * MiB, WS_HS2 = WS_HS, WS_QK = 496 * MiB,
                 WS_MIX = 345 * MiB, WS_S1 = 409 * MiB, WS_GATES = 473 * MiB, WS_SS = 474 * MiB, WS_HCD = 478 * MiB, WS_LAGG = WS_HCD + MiB / 2, WS_LCAR = WS_LAGG + MiB, WS_END = 512 * MiB;
constexpr int C_AQ = 0, C_AF = 256, C_AI = 512, C_AG = 768, C_BQ = 1024, C_BK = 1536, C_BV = 2048, C_BZ = 2560, C_CX = 3072, C_CY = 3328;
enum { I_X = 0, I_N1G, I_WIN, I_LB, I_HNG, I_GCW, I_GALOG, I_GDT, I_GNG, I_LCW, I_LCB, I_LWA, I_LBA, I_LWX, I_LBX, I_LLAM, I_WOUT, I_N2G, I_WUP, I_WDN, I_FNG };
struct Params { const float* in[21]; float* out; unsigned char* ws; };

__device__ __forceinline__ float bf2f(bf16_t v) { return __uint_as_float(((unsigned)v) << 16); }
__device__ __forceinline__ bf16_t f2bf(float f) { unsigned u = __float_as_uint(f); u += 0x7FFFu + ((u >> 16) & 1u); return (bf16_t)(u >> 16); }
__device__ __forceinline__ float lo_bf(unsigned w) { return __uint_as_float(w << 16); }
__device__ __forceinline__ float hi_bf(unsigned w) { return __uint_as_float(w & 0xffff0000u); }
__device__ __forceinline__ float sigm(float x) { return 1.f / (1.f + __expf(-x)); }
__device__ __forceinline__ float silu(float x) { return x * sigm(x); }
__device__ __forceinline__ float softplus(float x) { return fmaxf(x, 0.f) + log1pf(__expf(-fabsf(x))); }
__device__ __forceinline__ float gelu_tanh(float y) { const float u = 0.7978845608028654f * (y + 0.044715f * y * y * y); return 0.5f * y * (1.f + tanhf(u)); }
__device__ __forceinline__ float wave_sum(float v) {
#pragma unroll
    for (int o = 32; o; o >>= 1) v += __shfl_xor(v, o);
    return v;
}
__device__ __forceinline__ float row_rstd(const float* ssp, int row) {
    const f32x4 a = *(const f32x4*)(ssp + (size_t)row * 16), b = *(const f32x4*)(ssp + (size_t)row * 16 + 4), c = *(const f32x4*)(ssp + (size_t)row * 16 + 8), d = *(const f32x4*)(ssp + (size_t)row * 16 + 12);
    const f32x4 s = (a + b) + (c + d);
    return rsqrtf(((s[0] + s[1]) + (s[2] + s[3])) * (1.f / 1024.f) + EPS);
}
__device__ __forceinline__ float lower_bound(const float* lbl, int l, int c) {
    const float a0 = lbl[c], a1 = lbl[256 + c], a2 = lbl[512 + c], a3 = lbl[768 + c];
    const float m = fmaxf(fmaxf(a0, a1), fmaxf(a2, a3));
    const float e0 = expf(a0 - m), e1 = expf(a1 - m), e2 = expf(a2 - m), e3 = expf(a3 - m);
    const float inv = 1.f / (e0 + e1 + e2 + e3);
    float s = 0.f; if (l >= 1) s += e1; if (l >= 2) s += e2; if (l >= 3) s += e3;
    return fminf(fmaxf(s * inv, 0.f), 1.f - EPS);
}

template <int ACT  > struct EpiScaled {
    static constexpr bool PERM = true, AFTER_DRAIN = false;
    bf16_t* O; int ldc; const float* ss;
    __device__ __forceinline__ void operator()(const f32x4 (&acc)[2][2][4][2], const pg8::Unit& u, int wr, int wc, int fr, int fq) const {
        const int row0 = u.pm * 256 + wr * 64 + fr, col0 = u.pn * 256 + wc * 32 + 8 * fq;
#pragma unroll
        for (int ai = 0; ai < 2; ++ai)
#pragma unroll
            for (int m = 0; m < 4; ++m) {
                const int row = row0 + ai * 128 + m * 16;
                float sq; { const f32x4 a = *(const f32x4*)(ss + (size_t)row * 16 + fq * 4); sq = (a[0] + a[1]) + (a[2] + a[3]); }
                sq += __shfl_xor(sq, 16); sq += __shfl_xor(sq, 32);
                const float rs = rsqrtf(sq * (1.f / 1024.f) + EPS);
                bf16_t* rowp = O + (size_t)row * ldc + col0;
#pragma unroll
                for (int bj = 0; bj < 2; ++bj) {
                    f32x4 v0 = acc[ai][bj][m][0] * rs, v1 = acc[ai][bj][m][1] * rs;
                    if (ACT == 1) {
#pragma unroll
                        for (int j = 0; j < 4; ++j) { const float a = fmaxf(v0[j], 0.f), b = fmaxf(v1[j], 0.f); v0[j] = a * a; v1[j] = b * b; }
                    }
                    u32x4 w; w.x = cvt_pk_bf16(v0[0], v0[1]); w.y = cvt_pk_bf16(v0[2], v0[3]); w.z = cvt_pk_bf16(v1[0], v1[1]); w.w = cvt_pk_bf16(v1[2], v1[3]);
                    *(u32x4*)(rowp + bj * 128) = w;
                }
            }
    }
};
struct EpiResid {
    static constexpr bool PERM = true, AFTER_DRAIN = false;
    const float* Xsrc; float* X; bf16_t* XB; float* ssout;
    __device__ __forceinline__ void operator()(const f32x4 (&acc)[2][2][4][2], const pg8::Unit& u, int wr, int wc, int fr, int fq) const {
        const int row0 = u.pm * 256 + wr * 64 + fr, col0 = u.pn * 256 + wc * 32 + 8 * fq;
#pragma unroll
        for (int ai = 0; ai < 2; ++ai)
#pragma unroll
            for (int m = 0; m < 4; ++m) {
                const int row = row0 + ai * 128 + m * 16;
                const float* sp = Xsrc + (size_t)row * 1024 + col0; float* xp = X + (size_t)row * 1024 + col0; bf16_t* bp = XB + (size_t)row * 1024 + col0;
                float sq = 0.f;
#pragma unroll
                for (int bj = 0; bj < 2; ++bj) {
                    f32x4 v0 = *(const f32x4*)(sp + bj * 128) + acc[ai][bj][m][0], v1 = *(const f32x4*)(sp + bj * 128 + 4) + acc[ai][bj][m][1];
                    *(f32x4*)(xp + bj * 128) = v0; *(f32x4*)(xp + bj * 128 + 4) = v1;
                    u32x4 w; w.x = cvt_pk_bf16(v0[0], v0[1]); w.y = cvt_pk_bf16(v0[2], v0[3]); w.z = cvt_pk_bf16(v1[0], v1[1]); w.w = cvt_pk_bf16(v1[2], v1[3]);
                    *(u32x4*)(bp + bj * 128) = w;
#pragma unroll
                    for (int j = 0; j < 4; ++j) sq += v0[j] * v0[j] + v1[j] * v1[j];
                }
                sq += __shfl_xor(sq, 16); sq += __shfl_xor(sq, 32);
                if (fq == 0) ssout[(size_t)row * 16 + u.pn * 4 + wc] = sq;
            }
    }
};

__device__ void convert_w(const float* W, int ldw, int gate_skip  , const float* g, bf16_t* Bt, int N, int K, float* tile  , int first, int stride) {
    const int tid = TID(), ntn = N / 64, ntk = K / 64, ntiles = ntn * ntk;
    const int r0 = tid >> 4, c4 = (tid & 15) * 4;
    f32x4 nv[2];
    if (first < ntiles) { const int tn = first % ntn, tk = first / ntn, scol = tn * 64 + ((gate_skip && tn * 64 >= 3072) ? 8 : 0);
        nv[0] = *(const f32x4*)(W + (size_t)(tk * 64 + r0) * ldw + scol + c4); nv[1] = *(const f32x4*)(W + (size_t)(tk * 64 + r0 + 32) * ldw + scol + c4); }
    for (int ti = first; ti < ntiles; ti += stride) {
        const int tn = ti % ntn, tk = ti / ntn;
        const f32x4 v0 = nv[0], v1 = nv[1];
        if (ti + stride < ntiles) { const int t2 = ti + stride, tn2 = t2 % ntn, tk2 = t2 / ntn, scol2 = tn2 * 64 + ((gate_skip && tn2 * 64 >= 3072) ? 8 : 0);
            nv[0] = *(const f32x4*)(W + (size_t)(tk2 * 64 + r0) * ldw + scol2 + c4); nv[1] = *(const f32x4*)(W + (size_t)(tk2 * 64 + r0 + 32) * ldw + scol2 + c4); }
        __syncthreads();
        { float* tp = tile + r0 * 65 + c4; tp[0] = v0[0]; tp[1] = v0[1]; tp[2] = v0[2]; tp[3] = v0[3]; }
        { float* tp = tile + (r0 + 32) * 65 + c4; tp[0] = v1[0]; tp[1] = v1[1]; tp[2] = v1[2]; tp[3] = v1[3]; }
        __syncthreads();
        const int n = tid >> 3, k8 = (tid & 7) * 8;
        float v[8];
#pragma unroll
        for (int j = 0; j < 8; ++j) { v[j] = tile[(k8 + j) * 65 + n]; if (g) v[j] *= g[tk * 64 + k8 + j]; }
        u32x4 w; w.x = cvt_pk_bf16(v[0], v[1]); w.y = cvt_pk_bf16(v[2], v[3]); w.z = cvt_pk_bf16(v[4], v[5]); w.w = cvt_pk_bf16(v[6], v[7]);
        *(u32x4*)(Bt + (size_t)(tn * 64 + n) * K + tk * 64 + k8) = w;
    }
    __syncthreads();
}

__device__ void phase_init(const Params& p, unsigned char* smem) {
    const int tid = TID(), lane = tid & 63, gw = BID() * 8 + (tid >> 6), nw = gridDim.x * 8;
    float* ss = (float*)(p.ws + WS_SS);
    bf16_t* xb = (bf16_t*)(p.ws + WS_XB);
    for (int row0 = gw; row0 < T; row0 += 4 * nw) {
        f32x4 v[4][4];
#pragma unroll
        for (int r = 0; r < 4; ++r) { const int row = row0 + r * nw;
#pragma unroll
            for (int i = 0; i < 4; ++i) v[r][i] = row < T ? *(const f32x4*)(p.in[I_X] + (size_t)row * 1024 + (i * 64 + lane) * 4) : (f32x4){0.f, 0.f, 0.f, 0.f}; }
#pragma unroll
        for (int r = 0; r < 4; ++r) { const int row = row0 + r * nw;
            if (row < T) {
                bf16_t* brow = xb + (size_t)row * 1024; float sq = 0.f;
#pragma unroll
                for (int i = 0; i < 4; ++i) {
                    uint2 w; w.x = cvt_pk_bf16(v[r][i][0], v[r][i][1]); w.y = cvt_pk_bf16(v[r][i][2], v[r][i][3]);
                    *(uint2*)(brow + (i * 64 + lane) * 4) = w;
                    sq += v[r][i][0] * v[r][i][0] + v[r][i][1] * v[r][i][1] + v[r][i][2] * v[r][i][2] + v[r][i][3] * v[r][i][3];
                }
                sq = wave_sum(sq);
                if (lane < 16) ss[(size_t)row * 16 + lane] = lane == 0 ? sq : 0.f;
            } }
    }
    convert_w(p.in[I_WIN], DIN, 1, p.in[I_N1G], (bf16_t*)(p.ws + WS_WIN), NP, DM, (float*)smem, BID(), gridDim.x);
}

__device__ void phase_gates(const Params& p, int l, unsigned char* smem) {
    const int tid = TID(), lane = tid & 63, wv = tid >> 6;
    float* wg = (float*)smem;
    const float* W = p.in[I_WIN] + (size_t)l * DM * DIN; const float* g = p.in[I_N1G] + l * DM;
    __syncthreads();
    for (int i = tid; i < 8192; i += 512) { const int j = i & 7, k = i >> 3; wg[j * 1024 + k] = W[(size_t)k * DIN + 3072 + j] * g[k]; }
    __syncthreads();
    const bf16_t* xb = (const bf16_t*)(p.ws + WS_XB); const float* ss = (const float*)(p.ws + WS_SS); float* gates = (float*)(p.ws + WS_GATES);
    for (int t = BID() * 8 + wv; t < T; t += gridDim.x * 8) {
        float acc[8];
#pragma unroll
        for (int j = 0; j < 8; ++j) acc[j] = 0.f;
#pragma unroll
        for (int c = 0; c < 2; ++c) {
            const u32x4 xv = *(const u32x4*)(xb + (size_t)t * 1024 + c * 512 + lane * 8);
            float xf[8] = {lo_bf(xv.x), hi_bf(xv.x), lo_bf(xv.y), hi_bf(xv.y), lo_bf(xv.z), hi_bf(xv.z), lo_bf(xv.w), hi_bf(xv.w)};
#pragma unroll
            for (int j = 0; j < 8; ++j) {
                const f32x4 w0 = *(const f32x4*)(wg + j * 1024 + c * 512 + lane * 8), w1 = *(const f32x4*)(wg + j * 1024 + c * 512 + lane * 8 + 4);
                acc[j] += xf[0] * w0[0] + xf[1] * w0[1] + xf[2] * w0[2] + xf[3] * w0[3] + xf[4] * w1[0] + xf[5] * w1[1] + xf[6] * w1[2] + xf[7] * w1[3];
            }
        }
        float mine = 0.f;
#pragma unroll
        for (int j = 0; j < 8; ++j) { const float s = wave_sum(acc[j]); if (lane == j) mine = s; }
        if (lane < 8) {
            const float val = mine * row_rstd(ss, t);
            float o;
            if (lane < 4) o = sigm(val);
            else { const int h = lane - 4; o = -expf(p.in[I_GALOG][l * 4 + h]) * softplus(val + p.in[I_GDT][l * 4 + h]); }
            gates[(size_t)t * 8 + lane] = o;
        }
    }
    __syncthreads();
}

__device__ void gdn_qk_prep(const Params& p, int l) {
    const int tid = TID(), lane = tid & 63, wv = tid >> 6;
    const bf16_t* proj = (const bf16_t*)(p.ws + WS_R);
    bf16_t* s1 = (bf16_t*)(p.ws + WS_S1);
    {
        const int cc = wv * 128 + lane * 2;
        const float* cw = p.in[I_GCW] + (size_t)l * 4 * 1536;
        float w[4][2];
#pragma unroll
        for (int j = 0; j < 4; ++j) { w[j][0] = cw[j * 1536 + cc]; w[j][1] = cw[j * 1536 + cc + 1]; }
        const float post = wv < 4 ? 0.08838834764831845f : 1.f;
        for (int tile = BID(); tile < T / 128; tile += gridDim.x) {
            const int t0 = tile * 128;
            float x[3][2];
#pragma unroll
            for (int j = 0; j < 3; ++j) {
                if ((t0 % SEQ) == 0) { x[j][0] = 0.f; x[j][1] = 0.f; }
                else { const unsigned v = *(const unsigned*)(proj + (size_t)(t0 - 3 + j) * NP + C_BQ + cc); x[j][0] = lo_bf(v); x[j][1] = hi_bf(v); }
            }
            for (int t = t0; t < t0 + 128; ++t) {
                const unsigned v = *(const unsigned*)(proj + (size_t)t * NP + C_BQ + cc);
                const float a = lo_bf(v), b = hi_bf(v);
                const float y0 = silu(w[0][0] * x[0][0] + w[1][0] * x[1][0] + w[2][0] * x[2][0] + w[3][0] * a);
                const float y1 = silu(w[0][1] * x[0][1] + w[1][1] * x[1][1] + w[2][1] * x[2][1] + w[3][1] * b);
                const float r = rsqrtf(wave_sum(y0 * y0 + y1 * y1) + EPS) * post;
                *(unsigned*)(s1 + (size_t)t * 1024 + cc) = cvt_pk_bf16(y0 * r, y1 * r);
                x[0][0] = x[1][0]; x[0][1] = x[1][1]; x[1][0] = x[2][0]; x[1][1] = x[2][1]; x[2][0] = a; x[2][1] = b;
            }
        }
    }
}

__device__ void gdn_naive(const Params& p, int l, int item) {
    const int lane = TID() & 63, dg = lane >> 4, e = lane & 15;
    const int b = item >> 5, h = (item >> 3) & 3, eg = item & 7, ce = h * 128 + eg * 16 + e;
    const bf16_t* proj = (const bf16_t*)(p.ws + WS_R); const bf16_t* s1 = (const bf16_t*)(p.ws + WS_S1); const float* gates = (const float*)(p.ws + WS_GATES);
    bf16_t* mix = (bf16_t*)(p.ws + WS_MIX);
    const float* cw = p.in[I_GCW] + (size_t)l * 4 * 1536 + 1024 + ce;
    const float w0 = cw[0], w1 = cw[1536], w2 = cw[2 * 1536], w3 = cw[3 * 1536];
    float S[32];
#pragma unroll
    for (int i = 0; i < 32; ++i) S[i] = 0.f;
    float v0 = 0.f, v1 = 0.f, v2 = 0.f;
    const size_t tb = (size_t)b * SEQ;
    u32x4 kn[4], qn[4]; float vn, bn, an;
    {
        const bf16_t* kp = s1 + tb * 1024 + 512 + h * 128 + dg * 32; const bf16_t* qp = s1 + tb * 1024 + h * 128 + dg * 32;
#pragma unroll
        for (int i = 0; i < 4; ++i) { kn[i] = *(const u32x4*)(kp + i * 8); qn[i] = *(const u32x4*)(qp + i * 8); }
        vn = bf2f(proj[tb * NP + C_BV + ce]); bn = gates[tb * 8 + h]; an = gates[tb * 8 + 4 + h];
    }
    for (int t = 0; t < SEQ; ++t) {
        u32x4 kc[4], qc[4];
#pragma unroll
        for (int i = 0; i < 4; ++i) { kc[i] = kn[i]; qc[i] = qn[i]; }
        const float v3 = vn, beta = bn, alpha = __expf(an);
        {
            const size_t tok = tb + (t + 1 < SEQ ? t + 1 : t);
            const bf16_t* kp = s1 + tok * 1024 + 512 + h * 128 + dg * 32; const bf16_t* qp = s1 + tok * 1024 + h * 128 + dg * 32;
#pragma unroll
            for (int i = 0; i < 4; ++i) { kn[i] = *(const u32x4*)(kp + i * 8); qn[i] = *(const u32x4*)(qp + i * 8); }
            vn = bf2f(proj[tok * NP + C_BV + ce]); bn = gates[tok * 8 + h]; an = gates[tok * 8 + 4 + h];
        }
        const float vt = silu(w0 * v0 + w1 * v1 + w2 * v2 + w3 * v3);
        v0 = v1; v1 = v2; v2 = v3;
        float kf[32], qf[32];
#pragma unroll
        for (int i = 0; i < 4; ++i) {
            kf[i * 8 + 0] = lo_bf(kc[i].x); kf[i * 8 + 1] = hi_bf(kc[i].x); kf[i * 8 + 2] = lo_bf(kc[i].y); kf[i * 8 + 3] = hi_bf(kc[i].y);
            kf[i * 8 + 4] = lo_bf(kc[i].z); kf[i * 8 + 5] = hi_bf(kc[i].z); kf[i * 8 + 6] = lo_bf(kc[i].w); kf[i * 8 + 7] = hi_bf(kc[i].w);
            qf[i * 8 + 0] = lo_bf(qc[i].x); qf[i * 8 + 1] = hi_bf(qc[i].x); qf[i * 8 + 2] = lo_bf(qc[i].y); qf[i * 8 + 3] = hi_bf(qc[i].y);
            qf[i * 8 + 4] = lo_bf(qc[i].z); qf[i * 8 + 5] = hi_bf(qc[i].z); qf[i * 8 + 6] = lo_bf(qc[i].w); qf[i * 8 + 7] = hi_bf(qc[i].w);
        }
        float k0 = 0.f, k1 = 0.f, k2 = 0.f, k3 = 0.f;
#pragma unroll
        for (int i = 0; i < 32; i += 4) { k0 += kf[i] * S[i]; k1 += kf[i + 1] * S[i + 1]; k2 += kf[i + 2] * S[i + 2]; k3 += kf[i + 3] * S[i + 3]; }
        float ks = (k0 + k1) + (k2 + k3);
        ks += __shfl_xor(ks, 16); ks += __shfl_xor(ks, 32);
        const float c = beta * (vt - alpha * ks);
        float o0 = 0.f, o1 = 0.f, o2 = 0.f, o3 = 0.f;
#pragma unroll
        for (int i = 0; i < 32; i += 4) {
            S[i] = alpha * S[i] + kf[i] * c; o0 += qf[i] * S[i];
            S[i + 1] = alpha * S[i + 1] + kf[i + 1] * c; o1 += qf[i + 1] * S[i + 1];
            S[i + 2] = alpha * S[i + 2] + kf[i + 2] * c; o2 += qf[i + 2] * S[i + 2];
            S[i + 3] = alpha * S[i + 3] + kf[i + 3] * c; o3 += qf[i + 3] * S[i + 3];
        }
        float o = (o0 + o1) + (o2 + o3);
        o += __shfl_xor(o, 16); o += __shfl_xor(o, 32);
        if (dg == 0) mix[(tb + t) * 1024 + 256 + ce] = f2bf(o);
    }
}
__device__ __forceinline__ f32x4 mma16(const bf16_t* A, int lda, const bf16_t* B, int ldb, int ksteps, f32x4 acc, int fr, int fq) {
    for (int ks = 0; ks < ksteps; ++ks) {
        const pg8::bf16x8 a = *(const pg8::bf16x8*)(A + fr * lda + ks * 32 + fq * 8), b = *(const pg8::bf16x8*)(B + fr * ldb + ks * 32 + fq * 8);
        acc = __builtin_amdgcn_mfma_f32_16x16x32_bf16(a, b, acc, 0, 0, 0);
    }
    return acc;
}
__device__ __forceinline__ uint2 pack4(float a, float b, float c, float d) { uint2 w; w.x = (unsigned)f2bf(a) | ((unsigned)f2bf(b) << 16); w.y = (unsigned)f2bf(c) | ((unsigned)f2bf(d) << 16); return w; }

constexpr int L_WT = 0, L_XCB = 8 * 64 * 72 * 2, L_XLD = 264, L_ZS = L_XCB + 64 * L_XLD * 2;
__device__ void lru_load_wt(const Params& p, int l, unsigned char* smem) {
    const int tid = TID(); bf16_t* wt = (bf16_t*)(smem + L_WT);
    __syncthreads();
#pragma unroll
    for (int i = 0; i < 8; ++i) {
        const int item = tid + 512 * i, g = item >> 9, d = (item >> 3) & 63, e8 = (item & 7) * 8;
        const float* src = p.in[(g >> 2) ? I_LWX : I_LWA] + (size_t)l * 4 * 64 * 64 + (size_t)(g & 3) * 64 * 64 + d * 64 + e8;
        const f32x4 a = *(const f32x4*)src, bq = *(const f32x4*)(src + 4);
        bf16_t* dst = wt + g * 4608 + e8 * 72 + d;
        dst[0] = f2bf(a[0]); dst[72] = f2bf(a[1]); dst[144] = f2bf(a[2]); dst[216] = f2bf(a[3]); dst[288] = f2bf(bq[0]); dst[360] = f2bf(bq[1]); dst[432] = f2bf(bq[2]); dst[504] = f2bf(bq[3]);
    }
    __syncthreads();
}
__device__ void lru_unit_a(const Params& p, int l, int unit, unsigned char* smem) {
    const int tid = TID(), lane = tid & 63, wv = tid >> 6, fr = lane & 15, fq = lane >> 4;
    const bf16_t* wt = (const bf16_t*)(smem + L_WT); bf16_t* xcb = (bf16_t*)(smem + L_XCB); bf16_t* zs = (bf16_t*)(smem + L_ZS);
    const bf16_t* proj = (const bf16_t*)(p.ws + WS_R); bf16_t* Z = (bf16_t*)(p.ws + WS_Z);
    const size_t tok0 = (size_t)unit * 64; const int pos0 = (unit & 127) * 64;
    const float* lcw = p.in[I_LCW] + (size_t)l * 4 * 256; const float* lcb = p.in[I_LCB] + l * 256;
    __syncthreads();
    {
        const int c = tid & 255, th = tid >> 8;
        const float w0 = lcw[c], w1 = lcw[256 + c], w2 = lcw[512 + c], w3 = lcw[768 + c], cb = lcb[c];
        const int tk0 = th * 32;
        float x0 = 0.f, x1 = 0.f, x2 = 0.f;
        if (pos0 + tk0 > 0) { const bf16_t* q = proj + (tok0 + tk0 - 3) * NP + C_CX + c; x0 = bf2f(q[0]); x1 = bf2f(q[NP]); x2 = bf2f(q[2 * NP]); }
#pragma unroll 8
        for (int tk = tk0; tk < tk0 + 32; ++tk) {
            const float x3 = bf2f(proj[(tok0 + tk) * NP + C_CX + c]);
            xcb[tk * L_XLD + c] = f2bf(w0 * x0 + w1 * x1 + w2 * x2 + w3 * x3 + cb);
            x0 = x1; x1 = x2; x2 = x3;
        }
    }
    __syncthreads();
    const int c = tid & 255;
    const float sp = softplus(-p.in[I_LLAM][l * 256 + c]);
    float P = 1.f, H = 0.f;
    for (int q = 0; q < 4; ++q) {
#pragma unroll
        for (int i = 0; i < 4; ++i) {
            const int id = wv * 4 + i, g = id >> 2, et = id & 3, gate = g >> 2, n = g & 3;
            const f32x4 acc = mma16(wt + g * 4608 + et * 16 * 72, 72, xcb + (q * 16) * L_XLD + n * 64, L_XLD, 2, (f32x4){0.f, 0.f, 0.f, 0.f}, fr, fq);
            const int e0 = et * 16 + fq * 4;
            const f32x4 bv = *(const f32x4*)(p.in[gate ? I_LBX : I_LBA] + l * 256 + n * 64 + e0);
            const uint2 zb = pack4(acc[0] + bv[0], acc[1] + bv[1], acc[2] + bv[2], acc[3] + bv[3]);
            *(uint2*)(zs + fr * 512 + gate * 256 + n * 64 + e0) = zb;
            *(uint2*)(Z + (tok0 + q * 16 + fr) * 512 + gate * 256 + n * 64 + e0) = zb;
        }
        __syncthreads();
        if (tid < 256) {
#pragma unroll
            for (int j = 0; j < 16; ++j) {
                const int tk = q * 16 + j;
                const float r = sigm(bf2f(zs[j * 512 + c])), ig = sigm(bf2f(zs[j * 512 + 256 + c]));
                const float log_a = -8.f * r * sp, a = __expf(log_a);
                const float mult = (pos0 + tk == 0) ? 1.f : sqrtf(fmaxf(-expm1f(2.f * log_a), EPS));
                H = a * H + mult * ig * bf2f(xcb[tk * L_XLD + c]); P *= a;
            }
        }
        __syncthreads();
    }
    if (tid < 256) ((float2*)(p.ws + WS_LAGG))[(size_t)unit * 256 + c] = make_float2(P, H);
}
__device__ void lru_carry(const Params& p, int gt  ) {
    const int b = gt >> 8, c = gt & 255;
    const float2* agg = (const float2*)(p.ws + WS_LAGG); float* car = (float*)(p.ws + WS_LCAR);
    float h = 0.f;
    for (int n0 = 0; n0 < 128; n0 += 8) {
        float2 a[8];
#pragma unroll
        for (int j = 0; j < 8; ++j) a[j] = agg[(size_t)(b * 128 + n0 + j) * 256 + c];
#pragma unroll
        for (int j = 0; j < 8; ++j) { car[(size_t)(b * 128 + n0 + j) * 256 + c] = h; h = a[j].x * h + a[j].y; }
    }
}
__device__ void lru_unit_c(const Params& p, int l, int unit, int c) {
    const bf16_t* proj = (const bf16_t*)(p.ws + WS_R); const bf16_t* Z = (const bf16_t*)(p.ws + WS_Z); bf16_t* mix = (bf16_t*)(p.ws + WS_MIX);
    const size_t tok0 = (size_t)unit * 64; const int pos0 = (unit & 127) * 64;
    const float* lcw = p.in[I_LCW] + (size_t)l * 4 * 256;
    const float w0 = lcw[c], w1 = lcw[256 + c], w2 = lcw[512 + c], w3 = lcw[768 + c], cb = p.in[I_LCB][l * 256 + c];
    const float sp = softplus(-p.in[I_LLAM][l * 256 + c]);
    float h = ((const float*)(p.ws + WS_LCAR))[(size_t)unit * 256 + c];
    float x0 = 0.f, x1 = 0.f, x2 = 0.f;
    if (pos0 > 0) { const bf16_t* q = proj + (tok0 - 3) * NP + C_CX + c; x0 = bf2f(q[0]); x1 = bf2f(q[NP]); x2 = bf2f(q[2 * NP]); }
    for (int g = 0; g < 8; ++g) {
        float zr[8], zi[8], xs[8], ys[8];
#pragma unroll
        for (int j = 0; j < 8; ++j) {
            const size_t tok = tok0 + g * 8 + j;
            zr[j] = bf2f(Z[tok * 512 + c]); zi[j] = bf2f(Z[tok * 512 + 256 + c]); xs[j] = bf2f(proj[tok * NP + C_CX + c]); ys[j] = bf2f(proj[tok * NP + C_CY + c]);
        }
        float o[8];
#pragma unroll
        for (int j = 0; j < 8; ++j) {
            const int tk = g * 8 + j;
            const float xcv = bf2f(f2bf(w0 * x0 + w1 * x1 + w2 * x2 + w3 * xs[j] + cb));
            x0 = x1; x1 = x2; x2 = xs[j];
            const float r = sigm(zr[j]), ig = sigm(zi[j]);
            const float log_a = -8.f * r * sp, a = __expf(log_a);
            const float mult = (pos0 + tk == 0) ? 1.f : sqrtf(fmaxf(-expm1f(2.f * log_a), EPS));
            h = a * h + mult * ig * xcv;
            o[j] = gelu_tanh(ys[j]) * h;
        }
#pragma unroll
        for (int j = 0; j < 8; ++j) mix[(tok0 + g * 8 + j) * 1024 + 768 + c] = f2bf(o[j]);
    }
}

constexpr int HT_LD = 72, HT_BYTES = 64 * HT_LD * 2, H_CUM_BYTES = 64 * 65 * 4;
__device__ __forceinline__ void hgrn_load(const Params& p, int unit, int tid, u32x4 (&pf)[3]) {
    const bf16_t* pr = (const bf16_t*)(p.ws + WS_R) + ((size_t)(unit >> 2) * 64 + (tid >> 3)) * NP + (unit & 3) * 64 + (tid & 7) * 8;
    pf[0] = *(const u32x4*)(pr + C_AQ); pf[1] = *(const u32x4*)(pr + C_AF); pf[2] = *(const u32x4*)(pr + C_AI);
}
template <bool OUT> __device__ void hgrn_unit(const Params& p, int l, int unit, int next_unit, u32x4 (&pf)[3], unsigned char* smem, const float* lbs  ) {
    const int tid = TID(), lane = tid & 63, wv = tid >> 6, fr = lane & 15, fq = lane >> 4;
    const int h = unit & 3; const size_t tok0 = (size_t)(unit >> 2) * 64;
    const bf16_t* proj = (const bf16_t*)(p.ws + WS_R);
    float* cum = (float*)smem;
    bf16_t* tA = (bf16_t*)(smem + H_CUM_BYTES);
    bf16_t* tV = tA + 64 * HT_LD;
    bf16_t* tQ = tV + 64 * HT_LD;
    bf16_t* tD = tQ + 64 * HT_LD;
    bf16_t* tP = tD + 64 * HT_LD;
    bf16_t* tS = tP + 64 * HT_LD;
    float* sqx = (float*)(tS + 64 * HT_LD);

#ifdef HGRN_PROBE_U
    bf16_t* hs = (bf16_t*)(p.ws + WS_HS) + (size_t)unit * 4096;
#else
    bf16_t* hs = (bf16_t*)(p.ws + (OUT ? WS_HS2 : WS_HS)) + (size_t)unit * 4096;
#endif
    const int t = tid >> 3, d0 = (tid & 7) * 8;
    const u32x4 raq = pf[0], raf = pf[1], rai = pf[2];
    if (next_unit < 2048) hgrn_load(p, next_unit, tid, pf);
    const float aq[8] = {lo_bf(raq.x), hi_bf(raq.x), lo_bf(raq.y), hi_bf(raq.y), lo_bf(raq.z), hi_bf(raq.z), lo_bf(raq.w), hi_bf(raq.w)};
    const float af[8] = {lo_bf(raf.x), hi_bf(raf.x), lo_bf(raf.y), hi_bf(raf.y), lo_bf(raf.z), hi_bf(raf.z), lo_bf(raf.w), hi_bf(raf.w)};
    const float vv[8] = {lo_bf(rai.x), hi_bf(rai.x), lo_bf(rai.y), hi_bf(rai.y), lo_bf(rai.z), hi_bf(rai.z), lo_bf(rai.w), hi_bf(rai.w)};
    float q[8], kk[8];
    __syncthreads();
#pragma unroll
    for (int j = 0; j < 8; ++j) {
        const float lb = lbs[h * 64 + d0 + j];
        const float ex = __expf(-fminf(fmaxf(af[j], -80.f), 80.f)), sg = 1.f / (1.f + ex);
        const float f = fmaxf(lb + (1.f - lb) * sg, 1e-30f);
        kk[j] = (1.f - lb) * (ex * sg);
        q[j] = aq[j] / (1.f + __expf(-aq[j]));
        cum[t * 65 + d0 + j] = __logf(f);
    }
    __syncthreads();
    if (tid < 64) { float run = 0.f;
#pragma unroll 8
        for (int s = 0; s < 64; ++s) { run += cum[s * 65 + tid]; cum[s * 65 + tid] = run; } }
    __syncthreads();
    if (!OUT) {
#pragma unroll
        for (int j = 0; j < 8; ++j) {
            const float cl = cum[63 * 65 + d0 + j], c = cum[t * 65 + d0 + j];
            tA[(d0 + j) * HT_LD + t] = f2bf(kk[j] * __expf(cl - c));
            tV[(d0 + j) * HT_LD + t] = f2bf(vv[j]);
            if (t == 0) ((float*)(p.ws + WS_HCD))[(size_t)unit * 64 + d0 + j] = __expf(cl);
        }
        __syncthreads();
#pragma unroll
        for (int i = 0; i < 2; ++i) {
            const int tile = wv * 2 + i, dt = tile >> 2, et = tile & 3;
            const f32x4 acc = mma16(tA + dt * 16 * HT_LD, HT_LD, tV + et * 16 * HT_LD, HT_LD, 2, (f32x4){0.f, 0.f, 0.f, 0.f}, fr, fq);
            *(uint2*)(hs + (et * 16 + fr) * 64 + dt * 16 + fq * 4) = pack4(acc[0], acc[1], acc[2], acc[3]);
        }
    } else {
        float qt[8], kt[8], qd[8];
#pragma unroll
        for (int j = 0; j < 8; ++j) {
            const float cr = cum[31 * 65 + d0 + j], c = cum[t * 65 + d0 + j];
            qt[j] = q[j] * __expf(fminf(c - cr, 80.f)); kt[j] = kk[j] * __expf(fminf(cr - c, 80.f)); qd[j] = q[j] * __expf(c);
            tV[(d0 + j) * HT_LD + t] = f2bf(vv[j]);
        }
        { u32x4 w; w.x = cvt_pk_bf16(qt[0], qt[1]); w.y = cvt_pk_bf16(qt[2], qt[3]); w.z = cvt_pk_bf16(qt[4], qt[5]); w.w = cvt_pk_bf16(qt[6], qt[7]); *(u32x4*)(tQ + t * HT_LD + d0) = w; }
        { u32x4 w; w.x = cvt_pk_bf16(kt[0], kt[1]); w.y = cvt_pk_bf16(kt[2], kt[3]); w.z = cvt_pk_bf16(kt[4], kt[5]); w.w = cvt_pk_bf16(kt[6], kt[7]); *(u32x4*)(tA + t * HT_LD + d0) = w; }
        *(u32x4*)(tS + t * HT_LD + d0) = *(const u32x4*)(hs + t * 64 + d0);
        { u32x4 w; w.x = cvt_pk_bf16(qd[0], qd[1]); w.y = cvt_pk_bf16(qd[2], qd[3]); w.z = cvt_pk_bf16(qd[4], qd[5]); w.w = cvt_pk_bf16(qd[6], qd[7]); *(u32x4*)(tD + t * HT_LD + d0) = w; }
        __syncthreads();
#pragma unroll
        for (int i = 0; i < 2; ++i) {
            const int tile = wv * 2 + i, si = tile >> 2, tj = tile & 3;
            f32x4 acc = {0.f, 0.f, 0.f, 0.f};
            if (si <= tj) acc = mma16(tA + si * 16 * HT_LD, HT_LD, tQ + tj * 16 * HT_LD, HT_LD, 2, acc, fr, fq);
            const int tt = tj * 16 + fr, s0 = si * 16 + fq * 4;
            *(uint2*)(tP + tt * HT_LD + s0) = pack4(s0 <= tt ? acc[0] : 0.f, s0 + 1 <= tt ? acc[1] : 0.f, s0 + 2 <= tt ? acc[2] : 0.f, s0 + 3 <= tt ? acc[3] : 0.f);
        }
        __syncthreads();
        {
            const int tj = wv & 3, eh = wv >> 2, tt = tj * 16 + fr;
            f32x4 o[2]; float ssq = 0.f;
#pragma unroll
            for (int i = 0; i < 2; ++i) {
                const int et = eh * 2 + i;
                f32x4 acc = mma16(tV + et * 16 * HT_LD, HT_LD, tP + tj * 16 * HT_LD, HT_LD, 2, (f32x4){0.f, 0.f, 0.f, 0.f}, fr, fq);
                acc = mma16(tS + et * 16 * HT_LD, HT_LD, tD + tj * 16 * HT_LD, HT_LD, 2, acc, fr, fq);
                o[i] = acc; ssq += acc[0] * acc[0] + acc[1] * acc[1] + acc[2] * acc[2] + acc[3] * acc[3];
            }
            ssq += __shfl_xor(ssq, 16); ssq += __shfl_xor(ssq, 32);
            if (fq == 0) sqx[eh * 64 + tt] = ssq;
            __syncthreads();
            const float r = rsqrtf((sqx[tt] + sqx[64 + tt]) * (1.f / 64.f) + EPS);
            const float* g = p.in[I_HNG] + l * 64; bf16_t* mix = (bf16_t*)(p.ws + WS_MIX);
#pragma unroll
            for (int i = 0; i < 2; ++i) {
                const int e = (eh * 2 + i) * 16 + fq * 4;
                const uint2 gz = *(const uint2*)(proj + (tok0 + tt) * NP + C_AG + h * 64 + e);
                const f32x4 gv = *(const f32x4*)(g + e);
                *(uint2*)(mix + (tok0 + tt) * 1024 + h * 64 + e) = pack4(o[i][0] * r * gv[0] * silu(lo_bf(gz.x)), o[i][1] * r * gv[1] * silu(hi_bf(gz.x)),
                                                                          o[i][2] * r * gv[2] * silu(lo_bf(gz.y)), o[i][3] * r * gv[3] * silu(hi_bf(gz.y)));
            }
        }
    }
}
__device__ void hgrn_scan(const Params& p, int gt  ) {
    const int bh = gt >> 10, e = (gt >> 4) & 63, d4 = (gt & 15) * 4, b = bh >> 2, h = bh & 3;
    const bf16_t* hs = (const bf16_t*)(p.ws + WS_HS); bf16_t* hs2 = (bf16_t*)(p.ws + WS_HS2); const float* cdb = (const float*)(p.ws + WS_HCD);
    float S[4] = {0.f, 0.f, 0.f, 0.f};
    uint2 u[4], un[4]; f32x4 cd[4], cdn[4];
#pragma unroll
    for (int j = 0; j < 4; ++j) { const size_t unit = (size_t)(b * 128 + j) * 4 + h; u[j] = *(const uint2*)(hs + unit * 4096 + e * 64 + d4); cd[j] = *(const f32x4*)(cdb + unit * 64 + d4); }
    for (int n0 = 0; n0 < 128; n0 += 4) {
        if (n0 + 4 < 128) {
#pragma unroll
            for (int j = 0; j < 4; ++j) { const size_t unit = (size_t)(b * 128 + n0 + 4 + j) * 4 + h; un[j] = *(const uint2*)(hs + unit * 4096 + e * 64 + d4); cdn[j] = *(const f32x4*)(cdb + unit * 64 + d4); }
        }
#pragma unroll
        for (int j = 0; j < 4; ++j) {
            const size_t unit = (size_t)(b * 128 + n0 + j) * 4 + h;
            *(uint2*)(hs2 + unit * 4096 + e * 64 + d4) = pack4(S[0], S[1], S[2], S[3]);
            S[0] = cd[j][0] * S[0] + lo_bf(u[j].x); S[1] = cd[j][1] * S[1] + hi_bf(u[j].x); S[2] = cd[j][2] * S[2] + lo_bf(u[j].y); S[3] = cd[j][3] * S[3] + hi_bf(u[j].y);
        }
#pragma unroll
        for (int j = 0; j < 4; ++j) { u[j] = un[j]; cd[j] = cdn[j]; }
    }
}

constexpr int G_TMP = 0, G_VF = 32768, G_QB = 65536, G_LDB = 136, G_KB = G_QB + 64 * G_LDB * 2, G_AS = G_KB + 64 * G_LDB * 2, G_LDA = 68, G_SC = G_AS + 64 * G_LDA * 4;
__device__ __forceinline__ int frag_off(int r, int k, int KS) { return ((r >> 4) * KS + (k >> 5)) * 512 + ((((k >> 3) & 3) * 16 + (r & 15)) << 3) + (k & 7); }
__device__ __forceinline__ void gdn_raw_load(const bf16_t* proj, int unit, int sect, int tid, u32x4 (&v)[3]) {
    const int h = unit & 3, n = (unit >> 2) & 127; const size_t tok0 = (size_t)(unit >> 2) * 64; const int pcol0 = C_BQ + sect * 512 + h * 128;
#pragma unroll
    for (int i = 0; i < 3; ++i) {
        const int idx = tid + 512 * i, r = idx >> 4, c8 = (idx & 15) * 8;
        v[i] = (u32x4){0u, 0u, 0u, 0u};
        if (idx < 67 * 16 && (n > 0 || r >= 3)) v[i] = *(const u32x4*)(proj + (tok0 + r - 3) * NP + pcol0 + c8);
    }
}
__device__ __forceinline__ void gdn_raw_store(bf16_t* raw, int tid, const u32x4 (&v)[3]) {
#pragma unroll
    for (int i = 0; i < 3; ++i) { const int idx = tid + 512 * i; if (idx < 67 * 16) *(u32x4*)(raw + (idx >> 4) * 128 + (idx & 15) * 8) = v[i]; }
}
__device__ __forceinline__ void gdn_conv16(const Params& p, int l, const bf16_t* raw, int wch, int rg, int c, float* out) {
    const float* cw = p.in[I_GCW] + (size_t)l * 4 * 1536 + wch;
    const float w0 = cw[0], w1 = cw[1536], w2 = cw[3072], w3 = cw[4608];
    const int t0 = rg * 16; const bf16_t* q = raw + t0 * 128 + c;
    float x0 = bf2f(q[0]), x1 = bf2f(q[128]), x2 = bf2f(q[256]);
#pragma unroll
    for (int i = 0; i < 16; ++i) {
        const float x3 = bf2f(q[(i + 3) * 128]);
        out[(t0 + i) * 128 + c] = silu(w0 * x0 + w1 * x1 + w2 * x2 + w3 * x3);
        x0 = x1; x1 = x2; x2 = x3;
    }
}
#ifndef PROBE_DUP
#define PROBE_DUP 0
#endif
#ifndef PROBE_SKIP
#define PROBE_SKIP 0
#endif
__device__ void gdn_unit_m1(const Params& p, int l, int unit, int next_unit, u32x4 (&pq)[3], u32x4 (&pk)[3], u32x4 (&pv)[3], unsigned char* smem, bool fin = true) {
    const int skip = fin ? 0 : PROBE_SKIP;
    const int tid = TID(), lane = tid & 63, wv = tid >> 6, fr = lane & 15, fq = lane >> 4;
    const int h = unit & 3, n = (unit >> 2) & 127; const size_t tok0 = (size_t)(unit >> 2) * 64;
    float* tmp = (float*)(smem + G_TMP); float* vf = (float*)(smem + G_VF);
    bf16_t* qb = (bf16_t*)(smem + G_QB); bf16_t* kb = (bf16_t*)(smem + G_KB);
    float* As = (float*)(smem + G_AS); float* gcs = (float*)(smem + G_SC); float* bts = gcs + 64; float* egc = gcs + 128;
    const bf16_t* proj = (const bf16_t*)(p.ws + WS_R); float* gates = (float*)(p.ws + WS_GATES);
    bf16_t* uw = (bf16_t*)(p.ws + WS_XB) + (size_t)unit * 16384; bf16_t* qk1 = (bf16_t*)(p.ws + WS_S1) + (size_t)unit * 16384; bf16_t* qko = (bf16_t*)(p.ws + WS_QK) + (size_t)unit * 4096;
    const int c = tid & 127, rg = tid >> 7;
    __syncthreads();
    gdn_raw_store(qb, tid, pq); gdn_raw_store(kb, tid, pk); gdn_raw_store((bf16_t*)As, tid, pv);
    if (next_unit < 2048) { gdn_raw_load(proj, next_unit, 0, tid, pq); gdn_raw_load(proj, next_unit, 1, tid, pk); gdn_raw_load(proj, next_unit, 2, tid, pv); }
    if (tid < 64) {
        float la = gates[(tok0 + tid) * 8 + 4 + h];
#pragma unroll
        for (int o = 1; o < 64; o <<= 1) { const float v = __shfl_up(la, o); if (lane >= o) la += v; }
        gcs[tid] = la; egc[tid] = __expf(la); bts[tid] = gates[(tok0 + tid) * 8 + h];
    }
    __syncthreads();
    gdn_conv16(p, l, qb, h * 128 + c, rg, c, tmp);
    gdn_conv16(p, l, kb, 512 + h * 128 + c, rg, c, vf);
    __syncthreads();
#pragma unroll
    for (int i = 0; i < 8; ++i) {
        const int t = wv * 8 + i; const float2 v = *(const float2*)(tmp + t * 128 + 2 * lane), v2 = *(const float2*)(vf + t * 128 + 2 * lane);
        const float r = rsqrtf(wave_sum(v.x * v.x + v.y * v.y) + EPS) * 0.08838834764831845f, r2 = rsqrtf(wave_sum(v2.x * v2.x + v2.y * v2.y) + EPS);
        *(unsigned*)(qb + t * G_LDB + 2 * lane) = (unsigned)f2bf(v.x * r) | ((unsigned)f2bf(v.y * r) << 16);
        *(unsigned*)(kb + t * G_LDB + 2 * lane) = (unsigned)f2bf(v2.x * r2) | ((unsigned)f2bf(v2.y * r2) << 16);
    }
    __syncthreads();
    gdn_conv16(p, l, (const bf16_t*)As, 1024 + h * 128 + c, rg, c, vf);
    __syncthreads();
#pragma unroll
    for (int i = 0; i < 4; ++i) {
        const int id = wv * 4 + i, kind = id >> 4, tile = id & 15, si = tile >> 2, tj = tile & 3;
        const int t = tj * 16 + fr, s0 = si * 16 + fq * 4;
        if (si <= tj) {
            const f32x4 acc = mma16(kb + si * 16 * G_LDB, G_LDB, (kind ? qb : kb) + tj * 16 * G_LDB, G_LDB, 4, (f32x4){0.f, 0.f, 0.f, 0.f}, fr, fq);
            const float gt = gcs[t]; const f32x4 gs = *(const f32x4*)(gcs + s0);
            float v[4];
#pragma unroll
            for (int j = 0; j < 4; ++j) v[j] = acc[j] * __expf(fminf(gt - gs[j], 0.f));
            if (kind == 0) { const float bt = bts[t];
                *(f32x4*)(As + t * G_LDA + s0) = (f32x4){s0 < t ? bt * v[0] : 0.f, s0 + 1 < t ? bt * v[1] : 0.f, s0 + 2 < t ? bt * v[2] : 0.f, s0 + 3 < t ? bt * v[3] : 0.f};
            } else *(uint2*)(qko + frag_off(t, s0, 2)) = pack4(s0 <= t ? v[0] : 0.f, s0 + 1 <= t ? v[1] : 0.f, s0 + 2 <= t ? v[2] : 0.f, s0 + 3 <= t ? v[3] : 0.f);
        } else if (kind == 1) *(uint2*)(qko + frag_off(t, s0, 2)) = make_uint2(0u, 0u);
    }
    __syncthreads();
    const float gcl = gcs[63];
    if (tid >= 256) {
        const int tt = tid - 256;
        { const int t = tt >> 2, d0 = (tt & 3) * 32; const float eg = egc[t];
#pragma unroll
          for (int g = 0; g < 4; ++g) { const u32x4 qv = *(const u32x4*)(qb + t * G_LDB + d0 + g * 8); u32x4 w;
              const uint2 lo = pack4(lo_bf(qv.x) * eg, hi_bf(qv.x) * eg, lo_bf(qv.y) * eg, hi_bf(qv.y) * eg), hi = pack4(lo_bf(qv.z) * eg, hi_bf(qv.z) * eg, lo_bf(qv.w) * eg, hi_bf(qv.w) * eg);
              w.x = lo.x; w.y = lo.y; w.z = hi.x; w.w = hi.y; *(u32x4*)(qk1 + frag_off(t, d0 + g * 8, 4)) = w; } }
        { const int d = tt >> 1, sh = (tt & 1) * 32;
#pragma unroll
          for (int g = 0; g < 4; ++g) { float v[8];
#pragma unroll
              for (int j = 0; j < 8; ++j) { const int s = sh + g * 8 + j; v[j] = bf2f(kb[s * G_LDB + d]) * __expf(gcl - gcs[s]); }
              u32x4 w; const uint2 lo = pack4(v[0], v[1], v[2], v[3]), hi = pack4(v[4], v[5], v[6], v[7]);
              w.x = lo.x; w.y = lo.y; w.z = hi.x; w.w = hi.y; *(u32x4*)(qk1 + 8192 + frag_off(d, sh + g * 8, 2)) = w; } }
        if (tt == 0 && fin) gates[tok0 * 8 + 4 + h] = gcl;
    }
    if (!(skip & 1)) {
#pragma unroll 1
        for (int I = 0; I < 4; ++I) {
            float ad[4][16];
#pragma unroll
            for (int jj = 0; jj < 4; ++jj)
#pragma unroll
                for (int s4 = 0; s4 < 4; ++s4) { const f32x4 a = *(const f32x4*)(As + (I * 16 + fq * 4 + jj) * G_LDA + I * 16 + s4 * 4); ad[jj][s4 * 4] = a[0]; ad[jj][s4 * 4 + 1] = a[1]; ad[jj][s4 * 4 + 2] = a[2]; ad[jj][s4 * 4 + 3] = a[3]; }
            float x[2][4]; float* X[2];
#pragma unroll
            for (int c2 = 0; c2 < 2; ++c2) {
                const int col = (wv * 2 + c2) * 16 + fr;
                X[c2] = (col < 128 ? vf : tmp) + (col & 127);
                f32x4 acc = {0.f, 0.f, 0.f, 0.f};
                for (int J = 0; J < I; ++J)
#pragma unroll
                    for (int kk = 0; kk < 4; ++kk)
                        acc = __builtin_amdgcn_mfma_f32_16x16x4f32(As[(I * 16 + fr) * G_LDA + J * 16 + kk * 4 + fq], X[c2][(J * 16 + kk * 4 + fq) * 128], acc, 0, 0, 0);
#pragma unroll
                for (int jj = 0; jj < 4; ++jj) { const int t = I * 16 + fq * 4 + jj;
                    const float rhs = (col < 128) ? bts[t] * X[c2][t * 128] : bts[t] * egc[t] * bf2f(kb[t * G_LDB + (col & 127)]);
                    x[c2][jj] = rhs - acc[jj]; }
            }
#pragma unroll
            for (int r = 0; r < 16; ++r) {
                const float xr0 = __shfl(x[0][r & 3], (r >> 2) * 16 + fr), xr1 = __shfl(x[1][r & 3], (r >> 2) * 16 + fr);
#pragma unroll
                for (int jj = 0; jj < 4; ++jj) { x[0][jj] -= ad[jj][r] * xr0; x[1][jj] -= ad[jj][r] * xr1; }
            }
#pragma unroll
            for (int c2 = 0; c2 < 2; ++c2)
#pragma unroll
                for (int jj = 0; jj < 4; ++jj) X[c2][(I * 16 + fq * 4 + jj) * 128] = x[c2][jj];
        }
    }
    __syncthreads();
#pragma unroll
    for (int i = 0; i < 2; ++i) {
        const int pc = tid + 512 * i, blk = pc >> 6, ln = pc & 63, t = (blk >> 2) * 16 + (ln & 15), k0 = (blk & 3) * 32 + (ln >> 4) * 8;
        const f32x4 a = *(const f32x4*)(tmp + t * 128 + k0), bq = *(const f32x4*)(tmp + t * 128 + k0 + 4);
        u32x4 w; const uint2 lo = pack4(a[0], a[1], a[2], a[3]), hi = pack4(bq[0], bq[1], bq[2], bq[3]); w.x = lo.x; w.y = lo.y; w.z = hi.x; w.w = hi.y;
        *(u32x4*)(uw + 8192 + pc * 8) = w;
    }
#pragma unroll
    for (int i = 0; i < 4; ++i) {
        const int pc = tid + 512 * i, blk = pc >> 6, ln = pc & 63, e = (blk >> 2) * 16 + (ln & 15), t0 = (blk & 3) * 16 + (ln >> 4) * 4;
        *(uint2*)(uw + pc * 4) = pack4(vf[t0 * 128 + e], vf[(t0 + 1) * 128 + e], vf[(t0 + 2) * 128 + e], vf[(t0 + 3) * 128 + e]);
    }
}
template <int DRY> __device__ void gdn_seq(const Params& p, int l, int item, unsigned char* smem) {
    const int tid = TID(), lane = tid & 63, wv = tid >> 6, fr = lane & 15, fq = lane >> 4;
    const int b = item >> 5, h = (item >> 3) & 3, es = item & 7, tt = wv & 3; const bool isq = wv >= 4;
    bf16_t* Sl = (bf16_t*)smem;
    bf16_t* Vn = (bf16_t*)(smem + 4352);
    bf16_t* Ot = (bf16_t*)(smem + 6656);
    const bf16_t* UW = (const bf16_t*)(p.ws + WS_XB); const bf16_t* QKD = (const bf16_t*)(p.ws + WS_S1); const bf16_t* QKB = (const bf16_t*)(p.ws + WS_QK);
    const float* gates = (const float*)(p.ws + WS_GATES); bf16_t* mix = (bf16_t*)(p.ws + WS_MIX);
    const int zoff = tid >> 20;
    __syncthreads();
    for (int i = tid; i < 16 * 136 / 2; i += 512) ((unsigned*)Sl)[i] = 0u;
    __syncthreads();
    f32x4 S = {0.f, 0.f, 0.f, 0.f};
    pg8::bf16x8 A4[4][4], K2[4][2], Q2[4][2]; uint2 UU[4]; float GL[4];
#define GDN_LOAD(nn, J) do { const size_t cu = (size_t)((b * 128 + (nn)) * 4 + h); \
        const bf16_t* ap = (isq ? QKD + cu * 16384 : UW + cu * 16384 + 8192) + tt * 2048 + lane * 8; \
        _Pragma("unroll") for (int ks = 0; ks < 4; ++ks) A4[J][ks] = *(const pg8::bf16x8*)(ap + ks * 512); \
        const bf16_t* kp = QKD + cu * 16384 + 8192 + wv * 1024 + lane * 8; K2[J][0] = *(const pg8::bf16x8*)kp; K2[J][1] = *(const pg8::bf16x8*)(kp + 512); \
        if (isq) { const bf16_t* qp = QKB + cu * 4096 + tt * 1024 + lane * 8; Q2[J][0] = *(const pg8::bf16x8*)qp; Q2[J][1] = *(const pg8::bf16x8*)(qp + 512); } \
        else UU[J] = *(const uint2*)(UW + cu * 16384 + ((es * 4 + tt) * 64 + lane) * 4); \
        GL[J] = gates[(size_t)(b * 128 + (nn)) * 512 + 4 + h + zoff]; } while (0)
#pragma unroll
    for (int j = 0; j < 4; ++j) GDN_LOAD(j, j);
    for (int n0 = 0; n0 < 128; n0 += 4) {
#pragma unroll
        for (int j = 0; j < 4; ++j) {
            const int n = n0 + j;
            f32x4 acc = {0.f, 0.f, 0.f, 0.f};
#pragma unroll
            for (int ks = 0; ks < 4; ++ks) acc = __builtin_amdgcn_mfma_f32_16x16x32_bf16(A4[j][ks], *(const pg8::bf16x8*)(Sl + fr * 136 + ks * 32 + fq * 8), acc, 0, 0, 0);
            if (!isq) *(uint2*)(Vn + fr * 72 + tt * 16 + fq * 4) = pack4(lo_bf(UU[j].x) - acc[0], hi_bf(UU[j].x) - acc[1], lo_bf(UU[j].y) - acc[2], hi_bf(UU[j].y) - acc[3]);
            __syncthreads();
            const float cd = __expf(GL[j]);
            f32x4 sacc = S * cd;
#pragma unroll
            for (int ks = 0; ks < 2; ++ks) sacc = __builtin_amdgcn_mfma_f32_16x16x32_bf16(K2[j][ks], *(const pg8::bf16x8*)(Vn + fr * 72 + ks * 32 + fq * 8), sacc, 0, 0, 0);
            S = sacc;
            if (isq) {
#pragma unroll
                for (int ks = 0; ks < 2; ++ks) acc = __builtin_amdgcn_mfma_f32_16x16x32_bf16(Q2[j][ks], *(const pg8::bf16x8*)(Vn + fr * 72 + ks * 32 + fq * 8), acc, 0, 0, 0);
                bf16_t* op = Ot + (tt * 16 + fq * 4) * 16 + fr;
                op[0] = f2bf(acc[0]); op[16] = f2bf(acc[1]); op[32] = f2bf(acc[2]); op[48] = f2bf(acc[3]);
            }
            *(uint2*)(Sl + fr * 136 + wv * 16 + fq * 4) = pack4(S[0], S[1], S[2], S[3]);
            __syncthreads();
            if (tid < 128)
                *(u32x4*)(mix + ((size_t)(b * 128 + n) * 64 + es * 8 + (tid >> 4)) * 1024 + 256 + h * 128 + (tid & 15) * 8) = *(const u32x4*)(Ot + tid * 8);
            if (DRY != 1) { const int nx = DRY == 2 ? j : (n + 4 < 128 ? n + 4 : 127); GDN_LOAD(nx, j); }
        }
    }
#undef GDN_LOAD
}

#ifndef HGRN_NAIVE
#define HGRN_NAIVE 0
#endif
#ifndef LRU_NAIVE
#define LRU_NAIVE 0
#endif
__device__ void hgrn_naive(const Params& p, int l, int item) {
    const int lane = TID() & 63, dg = lane >> 4, e = lane & 15;
    const int b = item >> 4, h = (item >> 2) & 3, eg = item & 3, ce = h * 64 + eg * 16 + e;
    const bf16_t* proj = (const bf16_t*)(p.ws + WS_R); bf16_t* mix = (bf16_t*)(p.ws + WS_MIX);
    const float lb = lower_bound(p.in[I_LB], l, h * 64 + lane);
    float S[16];
#pragma unroll
    for (int i = 0; i < 16; ++i) S[i] = 0.f;
    const size_t tb = (size_t)b * SEQ;
    float fpn = bf2f(proj[tb * NP + C_AF + h * 64 + lane]), aqn = bf2f(proj[tb * NP + C_AQ + h * 64 + lane]), vn = bf2f(proj[tb * NP + C_AI + ce]);
    for (int t = 0; t < SEQ; ++t) {
        const float fp = fpn, aq = aqn, v = vn;
        {
            const size_t tok = tb + (t + 1 < SEQ ? t + 1 : t);
            fpn = bf2f(proj[tok * NP + C_AF + h * 64 + lane]); aqn = bf2f(proj[tok * NP + C_AQ + h * 64 + lane]); vn = bf2f(proj[tok * NP + C_AI + ce]);
        }
        const float sg = sigm(fp);
        const float f = fmaxf(lb + (1.f - lb) * sg, 1e-30f), k = (1.f - lb) * sigm(-fp), q = silu(aq);
        float o0 = 0.f, o1 = 0.f;
#pragma unroll
        for (int j = 0; j < 16; j += 2) {
            const int s0 = (lane & 48) | j, s1 = s0 + 1;
            const float f0 = __shfl(f, s0), kk0 = __shfl(k, s0), q0 = __shfl(q, s0), f1 = __shfl(f, s1), kk1 = __shfl(k, s1), q1 = __shfl(q, s1);
            S[j] = f0 * S[j] + kk0 * v; o0 += q0 * S[j];
            S[j + 1] = f1 * S[j + 1] + kk1 * v; o1 += q1 * S[j + 1];
        }
        float o = o0 + o1;
        o += __shfl_xor(o, 16); o += __shfl_xor(o, 32);
        if (dg == 0) mix[(tb + t) * 1024 + ce] = f2bf(o);
    }
}
__device__ void lru_naive(const Params& p, int l, int item) {
    const int lane = TID() & 63, b = item >> 2, c = (item & 3) * 64 + lane;
    const bf16_t* proj = (const bf16_t*)(p.ws + WS_R); const bf16_t* Z = (const bf16_t*)(p.ws + WS_Z); bf16_t* mix = (bf16_t*)(p.ws + WS_MIX);
    const float* lcw = p.in[I_LCW] + (size_t)l * 4 * 256 + c;
    const float w0 = lcw[0], w1 = lcw[256], w2 = lcw[512], w3 = lcw[768], cb = p.in[I_LCB][l * 256 + c];
    const float sp = softplus(-p.in[I_LLAM][l * 256 + c]);
    float x0 = 0.f, x1 = 0.f, x2 = 0.f, hst = 0.f;
    const size_t tb = (size_t)b * SEQ;
    float xn = bf2f(proj[tb * NP + C_CX + c]), yn = bf2f(proj[tb * NP + C_CY + c]), zrn = bf2f(Z[tb * 512 + c]), zin = bf2f(Z[tb * 512 + 256 + c]);
    for (int t = 0; t < SEQ; ++t) {
        const float x3 = xn, y = yn, zr = zrn, zi = zin;
        {
            const size_t tok = tb + (t + 1 < SEQ ? t + 1 : t);
            xn = bf2f(proj[tok * NP + C_CX + c]); yn = bf2f(proj[tok * NP + C_CY + c]); zrn = bf2f(Z[tok * 512 + c]); zin = bf2f(Z[tok * 512 + 256 + c]);
        }
        const float xc = w0 * x0 + w1 * x1 + w2 * x2 + w3 * x3 + cb;
        x0 = x1; x1 = x2; x2 = x3;
        const float r = sigm(zr), ig = sigm(zi);
        const float log_a = -8.f * r * sp, a = __expf(log_a);
        const float mult = (t == 0) ? 1.f : sqrtf(fmaxf(-expm1f(2.f * log_a), EPS));
        hst = a * hst + mult * ig * xc;
        mix[(tb + t) * 1024 + 768 + c] = f2bf(gelu_tanh(y) * hst);
    }
}
__device__ unsigned g_bar[1024];
__device__ __forceinline__ unsigned xcc_id() { return (unsigned)__builtin_amdgcn_s_getreg((3 << 11) | 20) & 0xFu; }
__device__ __forceinline__ void grid_barrier(unsigned epoch, unsigned n_x, unsigned n_xcd, unsigned base_x, unsigned base_g) {
    asm volatile("s_waitcnt vmcnt(0) lgkmcnt(0)" ::: "memory");
    __syncthreads();
    if (threadIdx.x == 0) {
        const unsigned x = xcc_id() & 7u;
        const unsigned old = __hip_atomic_fetch_add(&g_bar[x * 64], 1u, __ATOMIC_RELAXED, __HIP_MEMORY_SCOPE_AGENT);
        if (old + 1u - base_x == epoch * n_x) {
            __builtin_amdgcn_fence(__ATOMIC_RELEASE, "agent");
            __hip_atomic_fetch_add(&g_bar[512], 1u, __ATOMIC_RELAXED, __HIP_MEMORY_SCOPE_AGENT);
        }
        while (__hip_atomic_load(&g_bar[512], __ATOMIC_RELAXED, __HIP_MEMORY_SCOPE_AGENT) - base_g < epoch * n_xcd) __builtin_amdgcn_s_sleep(1);
        __builtin_amdgcn_fence(__ATOMIC_ACQUIRE, "agent");
    }
    __syncthreads();
}
__device__ __forceinline__ void sub_barrier(unsigned epoch, unsigned n, unsigned base) {
    asm volatile("s_waitcnt vmcnt(0) lgkmcnt(0)" ::: "memory");
    __syncthreads();
    if (threadIdx.x == 0) {
        __builtin_amdgcn_fence(__ATOMIC_RELEASE, "agent");
        __hip_atomic_fetch_add(&g_bar[640], 1u, __ATOMIC_RELAXED, __HIP_MEMORY_SCOPE_AGENT);
        while (__hip_atomic_load(&g_bar[640], __ATOMIC_RELAXED, __HIP_MEMORY_SCOPE_AGENT) - base < epoch * n) __builtin_amdgcn_s_sleep(1);
        __builtin_amdgcn_fence(__ATOMIC_ACQUIRE, "agent");
    }
    __syncthreads();
}
__device__ void phase_m1(const Params& p, int l, unsigned char* smem) {
    {
        u32x4 pq[3], pk[3], pv[3]; const bf16_t* proj = (const bf16_t*)(p.ws + WS_R);
        if (PROBE_DUP & 1) { gdn_raw_load(proj, BID(), 0, TID(), pq); gdn_raw_load(proj, BID(), 1, TID(), pk); gdn_raw_load(proj, BID(), 2, TID(), pv);
            for (int u = BID(); u < 2048; u += gridDim.x) gdn_unit_m1(p, l, u, u + (int)gridDim.x, pq, pk, pv, smem, false); }
        gdn_raw_load(proj, BID(), 0, TID(), pq); gdn_raw_load(proj, BID(), 1, TID(), pk); gdn_raw_load(proj, BID(), 2, TID(), pv);
        for (int u = BID(); u < 2048; u += gridDim.x) gdn_unit_m1(p, l, u, u + (int)gridDim.x, pq, pk, pv, smem);
    }
    lru_load_wt(p, l, smem);
    if (PROBE_DUP & 128) for (int u = BID(); u < 512; u += gridDim.x) lru_unit_a(p, l, u, smem);
    for (int u = BID(); u < 512; u += gridDim.x) lru_unit_a(p, l, u, smem);
    __syncthreads();
    float* lbs = (float*)(smem + 120 * 1024);
    if (TID() < 256) lbs[TID()] = lower_bound(p.in[I_LB], l, TID());
    __syncthreads();
    if (!HGRN_NAIVE) { u32x4 hp[3]; hgrn_load(p, BID(), TID(), hp);
        for (int u = BID(); u < 2048; u += gridDim.x) hgrn_unit<false>(p, l, u, u + (int)gridDim.x, hp, smem, lbs); }
}
#ifndef HG_SPLIT
#define HG_SPLIT 2048
#endif
__device__ void phase_m2(const Params& p, int l, unsigned char* smem, unsigned sub_base) {
    const int bid = BID(), tid = TID();
    if (bid < 128) { const int item = (((bid & 7) * 2 + (bid >> 6)) << 3) | ((bid >> 3) & 7);
        if (PROBE_DUP & 2) gdn_seq<0>(p, l, item, smem); if (PROBE_DUP & 16) gdn_seq<1>(p, l, item, smem); if (PROBE_DUP & 32) gdn_seq<2>(p, l, item, smem); gdn_seq<0>(p, l, item, smem); return; }
    const int hb = bid - 128, nhb = gridDim.x - 128;
    if (HGRN_NAIVE && hb < 64 && tid < 64) hgrn_naive(p, l, hb);
    if (LRU_NAIVE && hb >= 64 && hb < 80 && tid < 64) lru_naive(p, l, hb - 64);
    if (!HGRN_NAIVE && tid < 128) { for (int gt = hb * 128 + tid; gt < 16384; gt += nhb * 128) hgrn_scan(p, gt); }
    else if (!LRU_NAIVE && tid >= 128 && tid < 192) { for (int gt = hb * 64 + (tid - 128); gt < 1024; gt += nhb * 64) lru_carry(p, gt); }
    sub_barrier((unsigned)(l + 1), (unsigned)nhb, sub_base);
    {
        float* lbs = (float*)(smem + 120 * 1024);
        if (tid < 256) lbs[tid] = lower_bound(p.in[I_LB], l, tid);
        __syncthreads();
        { u32x4 hp[3]; hgrn_load(p, hb, tid, hp);
          for (int u = hb; u < HG_SPLIT; u += nhb) hgrn_unit<true>(p, l, u, (u + nhb < HG_SPLIT) ? u + nhb : 4096, hp, smem, lbs); }
        __syncthreads();
    }
}

__device__ void phase_m3(const Params& p, int l, unsigned char* smem) {
    const int tid = TID(), lane = tid & 63, wv = tid >> 6;
    const bf16_t* proj = (const bf16_t*)(p.ws + WS_R); bf16_t* mix = (bf16_t*)(p.ws + WS_MIX);
    {
        float* ssx = (float*)smem;
        const int r = tid >> 3, es = r >> 3, t = (r & 7) * 8 + (tid & 7);
        const int kstep = (int)(gridDim.x >> 3);
        u32x4 nv0, nv1, nz0, nz1;
        {
            const int k = BID() >> 3, pair = (BID() & 7) * 2 + (k >> 7), u = (((pair >> 2) * 128 + (k & 127)) << 2) | (pair & 3); const size_t tk0 = (size_t)(u >> 2) * 64;
            if (k < 256) { const u32x4* s_ = (const u32x4*)(mix + (tk0 + r) * 1024 + 256 + (u & 3) * 128 + (tid & 7) * 16); nv0 = s_[0]; nv1 = s_[1];
                const u32x4* z_ = (const u32x4*)(proj + (tk0 + t) * NP + C_BZ + (u & 3) * 128 + es * 16); nz0 = z_[0]; nz1 = z_[1]; }
        }
        for (int k = BID() >> 3; k < 256; k += kstep) {
            const int pair = (BID() & 7) * 2 + (k >> 7), n_ = k & 127, u = (((pair >> 2) * 128 + n_) << 2) | (pair & 3);
            const int h = u & 3; const size_t tok0 = (size_t)(u >> 2) * 64;
            const u32x4 v0 = nv0, v1 = nv1, z0 = nz0, z1 = nz1;
            if (k + kstep < 256) {
                const int k2 = k + kstep, pair2 = (BID() & 7) * 2 + (k2 >> 7), u2 = (((pair2 >> 2) * 128 + (k2 & 127)) << 2) | (pair2 & 3); const size_t tk2 = (size_t)(u2 >> 2) * 64;
                const u32x4* s_ = (const u32x4*)(mix + (tk2 + r) * 1024 + 256 + (u2 & 3) * 128 + (tid & 7) * 16); nv0 = s_[0]; nv1 = s_[1];
                const u32x4* z_ = (const u32x4*)(proj + (tk2 + t) * NP + C_BZ + (u2 & 3) * 128 + es * 16); nz0 = z_[0]; nz1 = z_[1];
            }
            float o[16] = {lo_bf(v0.x), hi_bf(v0.x), lo_bf(v0.y), hi_bf(v0.y), lo_bf(v0.z), hi_bf(v0.z), lo_bf(v0.w), hi_bf(v0.w), lo_bf(v1.x), hi_bf(v1.x), lo_bf(v1.y), hi_bf(v1.y), lo_bf(v1.z), hi_bf(v1.z), lo_bf(v1.w), hi_bf(v1.w)};
            float sq = 0.f;
#pragma unroll
            for (int j = 0; j < 16; ++j) sq += o[j] * o[j];
            __syncthreads();
            ssx[es * 64 + t] = sq;
            __syncthreads();
            float tot = 0.f;
#pragma unroll
            for (int k8 = 0; k8 < 8; ++k8) tot += ssx[k8 * 64 + t];
            const float rr = rsqrtf(tot * (1.f / 128.f) + EPS);
            const float zz[16] = {lo_bf(z0.x), hi_bf(z0.x), lo_bf(z0.y), hi_bf(z0.y), lo_bf(z0.z), hi_bf(z0.z), lo_bf(z0.w), hi_bf(z0.w), lo_bf(z1.x), hi_bf(z1.x), lo_bf(z1.y), hi_bf(z1.y), lo_bf(z1.z), hi_bf(z1.z), lo_bf(z1.w), hi_bf(z1.w)};
            const float* g = p.in[I_GNG] + l * 128 + es * 16;
            float y[16];
#pragma unroll
            for (int j = 0; j < 16; ++j) y[j] = o[j] * rr * g[j] * silu(zz[j]);
            u32x4 w0, w1;
            w0.x = cvt_pk_bf16(y[0], y[1]); w0.y = cvt_pk_bf16(y[2], y[3]); w0.z = cvt_pk_bf16(y[4], y[5]); w0.w = cvt_pk_bf16(y[6], y[7]);
            w1.x = cvt_pk_bf16(y[8], y[9]); w1.y = cvt_pk_bf16(y[10], y[11]); w1.z = cvt_pk_bf16(y[12], y[13]); w1.w = cvt_pk_bf16(y[14], y[15]);
            u32x4* dst = (u32x4*)(mix + (tok0 + t) * 1024 + 256 + h * 128 + es * 16);
            dst[0] = w0; dst[1] = w1;
        }
        __syncthreads();
    }
    for (int u0 = BID() * 2; u0 < 512; u0 += gridDim.x * 2) lru_unit_c(p, l, u0 + (tid >> 8), tid & 255);
    __syncthreads();
    {
    float* tile = (float*)smem;
    convert_w(p.in[I_WOUT] + (size_t)l * DM * DM, DM, 0, nullptr, (bf16_t*)(p.ws + WS_WOUT), DM, DM, tile, BID(), (int)gridDim.x);
    convert_w(p.in[I_WUP] + (size_t)l * DM * DFF, DFF, 0, p.in[I_N2G] + l * DM, (bf16_t*)(p.ws + WS_WUP), DFF, DM, tile, BID(), (int)gridDim.x);
    convert_w(p.in[I_WDN] + (size_t)l * DFF * DM, DM, 0, nullptr, (bf16_t*)(p.ws + WS_WDN), DM, DFF, tile, BID(), (int)gridDim.x);
    if (l + 1 < DEPTH) convert_w(p.in[I_WIN] + (size_t)(l + 1) * DM * DIN, DIN, 1, p.in[I_N1G] + (l + 1) * DM, (bf16_t*)(p.ws + WS_WIN), NP, DM, tile, BID(), (int)gridDim.x);
    }
    if (HG_SPLIT < 2048) {
        __syncthreads();
        float* lbs = (float*)(smem + 120 * 1024);
        if (tid < 256) lbs[tid] = lower_bound(p.in[I_LB], l, tid);
        __syncthreads();
        { u32x4 hp[3]; if (HG_SPLIT + BID() < 2048) hgrn_load(p, HG_SPLIT + BID(), tid, hp);
          for (int u = HG_SPLIT + BID(); u < 2048; u += gridDim.x) hgrn_unit<true>(p, l, u, u + (int)gridDim.x, hp, smem, lbs); }
    }
}

__device__ void phase_final(const Params& p) {
    const int tid = TID(), lane = tid & 63, gw = BID() * 8 + (tid >> 6), nw = gridDim.x * 8;
    const float* ss = (const float*)(p.ws + WS_SS); const float* g = p.in[I_FNG];
    f32x4 gv[4];
#pragma unroll
    for (int i = 0; i < 4; ++i) gv[i] = *(const f32x4*)(g + (i * 64 + lane) * 4);
    for (int row0 = gw; row0 < T; row0 += 4 * nw) {
        f32x4 v[4][4]; float rs[4];
#pragma unroll
        for (int r = 0; r < 4; ++r) { const int row = row0 + r * nw < T ? row0 + r * nw : row0;
            rs[r] = row_rstd(ss, row);
#pragma unroll
            for (int i = 0; i < 4; ++i) v[r][i] = *(const f32x4*)(p.out + (size_t)row * 1024 + (i * 64 + lane) * 4); }
#pragma unroll
        for (int r = 0; r < 4; ++r) { const int row = row0 + r * nw;
            if (row < T) {
#pragma unroll
                for (int i = 0; i < 4; ++i) *(f32x4*)(p.out + (size_t)row * 1024 + (i * 64 + lane) * 4) = v[r][i] * rs[r] * gv[i]; } }
    }
}

constexpr int N_PHASES = 2 + 7 * DEPTH;
__device__ __forceinline__ void run_phase(const Params& p, int ph, unsigned char* smem, unsigned sub_base) {
    if (ph == 0) { phase_init(p, smem); return; }
    if (ph == N_PHASES - 1) { phase_final(p); return; }
    const int l = (ph - 1) / 7, k = (ph - 1) % 7;
    PG8_LAS unsigned char* lds = (PG8_LAS unsigned char*)smem;
    float* ss = (float*)(p.ws + WS_SS);
    pg8::StaticOrder S;
    if (k == 0) {
        pg8::Gemm g{(const bf16_t*)(p.ws + WS_XB), (const bf16_t*)(p.ws + WS_WIN), T, NP, DM}; S.init(T, NP, gridDim.x, BID());
        EpiScaled<0> E{(bf16_t*)(p.ws + WS_R), NP, ss};
        if (PROBE_DUP & 8) pg8::gemm_phase<EpiScaled<0>, pg8::StaticOrder, true, true>(lds, g, S, E);
        pg8::gemm_phase<EpiScaled<0>, pg8::StaticOrder, true, true>(lds, g, S, E);
        if (PROBE_DUP & 128) phase_gates(p, l, smem);
        phase_gates(p, l, smem);
    } else if (k == 1) phase_m1(p, l, smem);
    else if (k == 2) phase_m2(p, l, smem, sub_base);
    else if (k == 3) phase_m3(p, l, smem);
    else if (k == 4 || k == 6) {
        pg8::Gemm g{(const bf16_t*)(p.ws + (k == 4 ? WS_MIX : WS_R)), (const bf16_t*)(p.ws + (k == 4 ? WS_WOUT : WS_WDN)), T, DM, k == 4 ? DM : DFF}; S.init(T, DM, gridDim.x, BID());
        EpiResid E{(l == 0 && k == 4) ? p.in[I_X] : (const float*)p.out, p.out, (bf16_t*)(p.ws + WS_XB), ss + (size_t)(k == 4 ? 1 : 0) * T * 16};
        pg8::gemm_phase<EpiResid, pg8::StaticOrder, true, true>(lds, g, S, E);
    } else {
        pg8::Gemm g{(const bf16_t*)(p.ws + WS_XB), (const bf16_t*)(p.ws + WS_WUP), T, DFF, DM}; S.init(T, DFF, gridDim.x, BID());
        EpiScaled<1> E{(bf16_t*)(p.ws + WS_R), DFF, ss + (size_t)T * 16};
        if (PROBE_DUP & 256) pg8::gemm_phase<EpiScaled<1>, pg8::StaticOrder, true, true>(lds, g, S, E);
        pg8::gemm_phase<EpiScaled<1>, pg8::StaticOrder, true, true>(lds, g, S, E);
    }
}

#ifndef MK_COOP
#define MK_COOP 1
#endif
__global__ __launch_bounds__(512, 2) void mk_fwd(Params p, int ph_lo, int ph_hi) {
    extern __shared__ __attribute__((aligned(16))) unsigned char shm[];
    unsigned bar_epoch = 0, bar_nx = 0, bar_nxcd = 0;
    const unsigned my_xcc = xcc_id() & 7u;
    const unsigned bar_bx = __hip_atomic_load(&g_bar[my_xcc * 64], __ATOMIC_RELAXED, __HIP_MEMORY_SCOPE_AGENT), bar_bg = __hip_atomic_load(&g_bar[512], __ATOMIC_RELAXED, __HIP_MEMORY_SCOPE_AGENT), bar_bs = __hip_atomic_load(&g_bar[640], __ATOMIC_RELAXED, __HIP_MEMORY_SCOPE_AGENT);
    if (MK_COOP && threadIdx.x == 0) ((unsigned*)(p.ws + WS_Z))[blockIdx.x] = my_xcc;
    for (int ph = ph_lo; ph < ph_hi; ++ph) {
        const __attribute__((address_space(4))) Params* pp = (const __attribute__((address_space(4))) Params*)__builtin_amdgcn_kernarg_segment_ptr();
        asm volatile("" : "+s"(pp));
        Params q;
#pragma unroll
        for (int i = 0; i < 21; ++i) q.in[i] = pp->in[i];
        q.out = pp->out; q.ws = pp->ws;
        run_phase(q, ph, shm, bar_bs);
#if MK_COOP
        if (ph + 1 < ph_hi) {
            if (ph == ph_lo) {
                asm volatile("s_waitcnt vmcnt(0) lgkmcnt(0)" ::: "memory"); __syncthreads(); cg::this_grid().sync();
                unsigned seen = 0u;
                for (unsigned i = 0; i < gridDim.x; ++i) { const unsigned v = __hip_atomic_load((unsigned*)(p.ws + WS_Z) + i, __ATOMIC_RELAXED, __HIP_MEMORY_SCOPE_AGENT) & 7u; bar_nx += (v == my_xcc) ? 1u : 0u; seen |= 1u << v; }
                bar_nxcd = (unsigned)__builtin_popcount(seen);
            } else grid_barrier(++bar_epoch, bar_nx, bar_nxcd, bar_bx, bar_bg);
        }
#endif
    }
}

extern "C" void kernel_launch(void* const* d_in, const int* in_sizes, int n_in, void* d_out, int out_size, void* d_ws, size_t ws_size, hipStream_t stream) {
    static int grid = 0;
    constexpr int LDS_BYTES = 131072;
    if (grid == 0) {
        if (n_in != 21 || out_size != T * DM || ws_size < WS_END) { fprintf(stderr, "kernel_launch: unexpected shapes (n_in %d out %d ws %zu)\n", n_in, out_size, ws_size); grid = -1; return; }
        int dev = 0, cus = 0, per_cu = 0;
        hipGetDevice(&dev); hipDeviceGetAttribute(&cus, hipDeviceAttributeMultiprocessorCount, dev);
        if (hipFuncSetAttribute((const void*)mk_fwd, hipFuncAttributeMaxDynamicSharedMemorySize, LDS_BYTES) != hipSuccess) { fprintf(stderr, "kernel_launch: hipFuncSetAttribute failed\n"); grid = -1; return; }
        if (hipOccupancyMaxActiveBlocksPerMultiprocessor(&per_cu, (const void*)mk_fwd, 512, LDS_BYTES) != hipSuccess || per_cu < 1) { fprintf(stderr, "kernel_launch: occupancy query gave %d\n", per_cu); per_cu = 1; }
        (void)hipGetLastError();
        grid = cus * 1;
    }
    if (grid < 0) return;
    Params p{};
    for (int i = 0; i < 21; ++i) p.in[i] = (const float*)d_in[i];
    p.out = (float*)d_out; p.ws = (unsigned char*)d_ws;
#if MK_COOP
    int lo = 0, hi = N_PHASES;
    void* args[] = {&p, &lo, &hi};
    hipError_t e = hipLaunchCooperativeKernel((const void*)mk_fwd, dim3(grid), dim3(512), args, LDS_BYTES, stream);
    if (e != hipSuccess) fprintf(stderr, "cooperative launch failed: %s (grid %d)\n", hipGetErrorString(e), grid);
#else
    for (int ph = 0; ph < N_PHASES; ++ph) hipLaunchKernelGGL(mk_fwd, dim3(grid), dim3(512), LDS_BYTES, stream, p, ph, ph + 1);
#endif
}
```
